# Optimizing an MI355X kernel written in HIP

```python
import jax, jax.numpy as jnp
from jax import lax
import numpy as np

D_MODEL = 2048
BATCH = 4
SEQ = 2048
DEPTH = 1
DEC_BATCH = 32
DEC_SEQ = 32
PAST_LEN = 1024

CHUNK = 64
N_HEADS = 16
QK_NOPE = 128
QK_ROPE = 64
V_HEAD = 128
Q_LORA = 512
KV_LORA = 512
POOL_WINDOWS = (2, 4, 8, 16)
POOL_GROUPS = len(POOL_WINDOWS)
POOL_WIDTH = D_MODEL // 2
POOL_GC = POOL_WIDTH // POOL_GROUPS
POOL_HIST = max(POOL_WINDOWS) - 1
D_FF = 5632
N_BRANCH = 2
D_IN = POOL_WIDTH + Q_LORA + KV_LORA + QK_ROPE + N_BRANCH * D_MODEL
ROPE_THETA = 10000.0
EPS = 1e-6
Q_BLOCK = 128
SM_SCALE = (QK_NOPE + QK_ROPE) ** -0.5
NEG_INF = -1e30

kernel_name = 'hybrid_pool_mla_macaron_stream_step'


def rmsnorm(x, g):
    xf = x.astype(jnp.float32)
    out = xf * lax.rsqrt(jnp.mean(xf * xf, axis=-1, keepdims=True) + EPS) * g.astype(jnp.float32)
    return out.astype(x.dtype)


def swiglu(x, w_gate, w_up, w_down):
    return (jax.nn.silu(x @ w_gate) * (x @ w_up)) @ w_down


def rope(x, pos):
    half = QK_ROPE // 2
    inv = ROPE_THETA ** (-jnp.arange(half, dtype=jnp.float32) * 2.0 / QK_ROPE)
    ang = pos.astype(jnp.float32)[:, None] * inv[None, :]
    if x.ndim == 4:
        ang = ang[:, None, :]
    c, s = jnp.cos(ang), jnp.sin(ang)
    xf = x.astype(jnp.float32)
    x1, x2 = xf[..., :half], xf[..., half:]
    return jnp.concatenate([x1 * c - x2 * s, x2 * c + x1 * s], axis=-1).astype(x.dtype)


def pool_mix(z_hist, z, pos, w_pool, pool_scale):
    B, T, P = z.shape
    L = z_hist.shape[1]
    z_ext = jnp.concatenate([z_hist, z], axis=1)
    cs = jnp.cumsum(z_ext.astype(jnp.float32), axis=1)
    cs = jnp.pad(cs, ((0, 0), (1, 0), (0, 0)))
    means = []
    for g, w in enumerate(POOL_WINDOWS):
        sl = slice(g * POOL_GC, (g + 1) * POOL_GC)
        s = cs[:, L + 1:L + 1 + T, sl] - cs[:, L + 1 - w:L + 1 - w + T, sl]
        cnt = jnp.minimum(pos + 1, w).astype(jnp.float32)[None, :, None]
        means.append(s / cnt)
    pooled = jnp.concatenate(means, axis=-1) - z.astype(jnp.float32)
    pooled = pooled.astype(z.dtype).reshape(B, T, POOL_GROUPS, POOL_GC)
    mixed = jnp.einsum('btgc,gcd->btgd', pooled, w_pool).reshape(B, T, P)
    return mixed * pool_scale, z_ext[:, -POOL_HIST:]


def mla_attend(q_nope, q_rope, ckv, k_rope, q_pos, k_pos, w_uk, w_uv):
    B, Tq = q_nope.shape[:2]
    k_nope = jnp.einsum('bsc,chd->bshd', ckv, w_uk)
    v = jnp.einsum('bsc,chd->bshd', ckv, w_uv)
    k_chunk = k_pos // CHUNK

    def attend_block(args):
        qn, qr, qp = args
        s = (jnp.einsum('bqhd,bshd->bhqs', qn, k_nope)
             + jnp.einsum('bqhr,bsr->bhqs', qr, k_rope)).astype(jnp.float32) * SM_SCALE
        mask = k_chunk[None, :] <= (qp // CHUNK)[:, None]
        s = jnp.where(mask[None, None], s, NEG_INF)
        p = jax.nn.softmax(s, axis=-1).astype(v.dtype)
        return jnp.einsum('bhqs,bshd->bqhd', p, v)

    if Tq > Q_BLOCK and Tq % Q_BLOCK == 0:
        nb = Tq // Q_BLOCK
        qn_b = q_nope.reshape(B, nb, Q_BLOCK, N_HEADS, QK_NOPE).transpose(1, 0, 2, 3, 4)
        qr_b = q_rope.reshape(B, nb, Q_BLOCK, N_HEADS, QK_ROPE).transpose(1, 0, 2, 3, 4)
        qp_b = q_pos.reshape(nb, Q_BLOCK)
        out = lax.map(attend_block, (qn_b, qr_b, qp_b))
        return out.transpose(1, 0, 2, 3, 4).reshape(B, Tq, N_HEADS, V_HEAD)
    return attend_block((q_nope, q_rope, q_pos))


def token_mix(u, pos, past_pos, pool_hist, ckv_past, krope_past, p):
    B, T, _ = u.shape
    proj = u @ p['w_in']
    o1 = POOL_WIDTH
    o2 = o1 + Q_LORA
    o3 = o2 + KV_LORA
    o4 = o3 + QK_ROPE
    z_pool = proj[..., :o1]
    q_lat = rmsnorm(proj[..., o1:o2], p['g_q_lat'])
    ckv = rmsnorm(proj[..., o2:o3], p['g_kv_lat'])
    krope = rope(proj[..., o3:o4], pos)
    gates = jax.nn.sigmoid(proj[..., o4:].astype(jnp.float32)).astype(u.dtype).reshape(B, T, N_BRANCH, D_MODEL)

    pooled, pool_tail = pool_mix(pool_hist, z_pool, pos, p['w_pool'], p['pool_scale'])
    a = pooled @ p['w_pool_out']

    q = jnp.einsum('btc,chd->bthd', q_lat, p['w_uq'])
    q_nope = q[..., :QK_NOPE]
    q_rope = rope(q[..., QK_NOPE:], pos)
    ckv_all = jnp.concatenate([ckv_past, ckv], axis=1)
    kr_all = jnp.concatenate([krope_past, krope], axis=1)
    k_pos = jnp.concatenate([past_pos, pos])
    o = mla_attend(q_nope, q_rope, ckv_all, kr_all, pos, k_pos, p['w_uk'], p['w_uv'])
    b = o.reshape(B, T, N_HEADS * V_HEAD) @ p['w_o_attn']

    merged = gates[:, :, 0] * a + gates[:, :, 1] * b
    return merged @ p['w_out'], ckv, krope, pool_tail


def layer(x, pos, past_pos, pool_hist, ckv_past, krope_past, p):
    h = x + 0.5 * swiglu(rmsnorm(x, p['g_ffn1']), p['w1_gate'], p['w1_up'], p['w1_down'])
    mix, ckv_new, kr_new, pool_tail = token_mix(rmsnorm(h, p['g_mix']), pos, past_pos,
                                                pool_hist, ckv_past, krope_past, p)
    h = h + mix
    h = h + 0.5 * swiglu(rmsnorm(h, p['g_ffn2']), p['w2_gate'], p['w2_up'], p['w2_down'])
    return h, ckv_new, kr_new, pool_tail


def setup_inputs(seed: int = 0) -> dict:
    key = jax.random.key(seed)
    ks = iter(jax.random.split(key, 40))
    f32 = jnp.float32

    def nrm(shape, scale):
        return jax.random.normal(next(ks), shape, f32) * scale

    def gain(shape):
        return 1.0 + 0.01 * jax.random.normal(next(ks), shape, f32)

    return {
        'x_prompt': nrm((BATCH, SEQ, D_MODEL), 1.0),
        'x_sample': nrm((DEC_BATCH, DEC_SEQ, D_MODEL), 1.0),
        'cache_ckv': nrm((DEPTH, DEC_BATCH, PAST_LEN, KV_LORA), 1.0),
        'cache_krope': nrm((DEPTH, DEC_BATCH, PAST_LEN, QK_ROPE), 1.0),
        'state_pool': nrm((DEPTH, DEC_BATCH, POOL_HIST, POOL_WIDTH), 1.0),
        'g_ffn1': gain((DEPTH, D_MODEL)),
        'w1_gate': nrm((DEPTH, D_MODEL, D_FF), D_MODEL ** -0.5),
        'w1_up': nrm((DEPTH, D_MODEL, D_FF), D_MODEL ** -0.5),
        'w1_down': nrm((DEPTH, D_FF, D_MODEL), D_FF ** -0.5),
        'g_mix': gain((DEPTH, D_MODEL)),
        'w_in': nrm((DEPTH, D_MODEL, D_IN), D_MODEL ** -0.5),
        'g_q_lat': gain((DEPTH, Q_LORA)),
        'g_kv_lat': gain((DEPTH, KV_LORA)),
        'w_uq': nrm((DEPTH, Q_LORA, N_HEADS, QK_NOPE + QK_ROPE), Q_LORA ** -0.5),
        'w_uk': nrm((DEPTH, KV_LORA, N_HEADS, QK_NOPE), KV_LORA ** -0.5),
        'w_uv': nrm((DEPTH, KV_LORA, N_HEADS, V_HEAD), KV_LORA ** -0.5),
        'w_o_attn': nrm((DEPTH, N_HEADS * V_HEAD, D_MODEL), (N_HEADS * V_HEAD) ** -0.5),
        'w_pool': nrm((DEPTH, POOL_GROUPS, POOL_GC, POOL_GC), POOL_GC ** -0.5),
        'pool_scale': gain((DEPTH, POOL_WIDTH)),
        'w_pool_out': nrm((DEPTH, POOL_WIDTH, D_MODEL), POOL_WIDTH ** -0.5),
        'w_out': nrm((DEPTH, D_MODEL, D_MODEL), D_MODEL ** -0.5),
        'g_ffn2': gain((DEPTH, D_MODEL)),
        'w2_gate': nrm((DEPTH, D_MODEL, D_FF), D_MODEL ** -0.5),
        'w2_up': nrm((DEPTH, D_MODEL, D_FF), D_MODEL ** -0.5),
        'w2_down': nrm((DEPTH, D_FF, D_MODEL), D_FF ** -0.5),
        'g_final': gain((D_MODEL,)),
    }


def reference(x_prompt, x_sample, cache_ckv, cache_krope, state_pool,
              g_ffn1, w1_gate, w1_up, w1_down, g_mix, w_in, g_q_lat, g_kv_lat,
              w_uq, w_uk, w_uv, w_o_attn, w_pool, pool_scale, w_pool_out, w_out,
              g_ffn2, w2_gate, w2_up, w2_down, g_final):
    Bp, Tp, _ = x_prompt.shape
    Bs, Ts, _ = x_sample.shape
    past = cache_ckv.shape[2]
    dt = x_prompt.dtype

    pos_p = jnp.arange(Tp, dtype=jnp.int32)
    past_pos_p = jnp.zeros((0,), jnp.int32)
    pos_s = past + jnp.arange(Ts, dtype=jnp.int32)
    past_pos_s = jnp.arange(past, dtype=jnp.int32)

    hp, hs = x_prompt, x_sample
    ckv_p, kr_p, pool_p, ckv_s, kr_s, pool_s = [], [], [], [], [], []
    for l in range(DEPTH):
        lw = {
            'g_ffn1': g_ffn1[l], 'w1_gate': w1_gate[l], 'w1_up': w1_up[l], 'w1_down': w1_down[l],
            'g_mix': g_mix[l], 'w_in': w_in[l], 'g_q_lat': g_q_lat[l], 'g_kv_lat': g_kv_lat[l],
            'w_uq': w_uq[l], 'w_uk': w_uk[l], 'w_uv': w_uv[l], 'w_o_attn': w_o_attn[l],
            'w_pool': w_pool[l], 'pool_scale': pool_scale[l], 'w_pool_out': w_pool_out[l],
            'w_out': w_out[l], 'g_ffn2': g_ffn2[l], 'w2_gate': w2_gate[l], 'w2_up': w2_up[l],
            'w2_down': w2_down[l],
        }
        hp, c1, k1, t1 = layer(hp, pos_p, past_pos_p,
                               jnp.zeros((Bp, POOL_HIST, POOL_WIDTH), dt),
                               jnp.zeros((Bp, 0, KV_LORA), dt),
                               jnp.zeros((Bp, 0, QK_ROPE), dt), lw)
        hs, c2, k2, t2 = layer(hs, pos_s, past_pos_s, state_pool[l].astype(hs.dtype),
                               cache_ckv[l].astype(hs.dtype), cache_krope[l].astype(hs.dtype), lw)
        ckv_p.append(c1); kr_p.append(k1); pool_p.append(t1)
        ckv_s.append(c2); kr_s.append(k2); pool_s.append(t2)

    y_prompt = rmsnorm(hp, g_final)
    y_sample = rmsnorm(hs, g_final)
    return (y_prompt, y_sample,
            jnp.stack(ckv_p), jnp.stack(kr_p), jnp.stack(pool_p),
            jnp.stack(ckv_s), jnp.stack(kr_s), jnp.stack(pool_s))
```

```cpp
#include <hip/hip_runtime.h>
#include <hip/hip_cooperative_groups.h>
#include <cstdio>
namespace cg = cooperative_groups;

#ifndef PHASE_MASK
#define PHASE_MASK 0x3ffff
#endif
#define PH_ON(n) (((PHASE_MASK) >> (n)) & 1)
#ifndef SINGLE_LAUNCH
#define SINGLE_LAUNCH 1
#endif

#define LAS __attribute__((address_space(3)))
#define GAS __attribute__((address_space(1)))
#define DI __device__ __forceinline__
typedef unsigned short bf16_t;
typedef short bf16x8 __attribute__((ext_vector_type(8)));
typedef float f32x4 __attribute__((ext_vector_type(4)));
typedef float f32x16 __attribute__((ext_vector_type(16)));
typedef unsigned u32x4 __attribute__((ext_vector_type(4)));
typedef unsigned u32x2 __attribute__((ext_vector_type(2)));
typedef _Float16 f16x4 __attribute__((ext_vector_type(4)));

constexpr int NTOK = 9216, NPT = 8192, NST = 1024, DM = 2048, DFF = 5632;
constexpr int NPHASE = 18;
constexpr float QSCALE = 0.07216878364870322f * 1.4426950408889634f;

constexpr size_t SZ_WGU = (size_t)11264 * 2048 * 2, SZ_WD = (size_t)2048 * 5632 * 2;
constexpr size_t OFF_WFF = 0;
constexpr size_t OFF_WGU = OFF_WFF, OFF_WD = OFF_WFF + SZ_WGU;
constexpr size_t SZ_WFF = SZ_WGU + SZ_WD;
constexpr size_t OFF_WIN = OFF_WFF + SZ_WFF;
constexpr size_t OFF_WUQ = OFF_WIN + (size_t)6400 * 2048 * 2;
constexpr size_t OFF_WUKT = OFF_WUQ + (size_t)3072 * 512 * 2;
constexpr size_t OFF_WUVT = OFF_WUKT + (size_t)2048 * 512 * 2;
constexpr size_t OFF_WOA = OFF_WUVT + (size_t)2176 * 512 * 2;
constexpr size_t OFF_WPOOL = OFF_WOA + (size_t)2048 * 2048 * 2;
constexpr size_t OFF_WPO = OFF_WPOOL + (size_t)4 * 256 * 256 * 2;
constexpr size_t OFF_WOUT = OFF_WPO + (size_t)2048 * 1024 * 2;
constexpr size_t OFF_XN = OFF_WOUT + (size_t)2048 * 2048 * 2;
constexpr size_t SZ_XN = (size_t)NTOK * 2048 * 2;
constexpr size_t OFF_G = OFF_XN + SZ_XN;
constexpr size_t SZ_G = (size_t)NTOK * DFF * 2;
constexpr size_t OFF_GATES = OFF_G + SZ_G;
constexpr size_t OFF_QN = OFF_GATES + (size_t)NTOK * 4096 * 2;
constexpr size_t OFF_O = OFF_QN + (size_t)NTOK * 2048 * 2;
constexpr size_t OFF_KALL = OFF_O + (size_t)NTOK * 2048 * 2;
constexpr size_t OFF_CKVT = OFF_KALL + (size_t)(32 * 1056 + 224) * 640 * 2;
constexpr size_t OFF_KRB = OFF_CKVT + (size_t)32 * 512 * 1152 * 2;
constexpr size_t OFF_HB = OFF_KRB + (size_t)NTOK * 64 * 2;
constexpr size_t WS_BAR = OFF_HB + (size_t)NTOK * 2048 * 2;
constexpr size_t WS_END = WS_BAR + 16384;
constexpr size_t OFF_Z = OFF_G;
constexpr size_t OFF_QLR = OFF_Z + (size_t)NTOK * 1024 * 4;
constexpr size_t OFF_CKR = OFF_QLR + (size_t)NTOK * 512 * 4;
constexpr size_t OFF_KN = OFF_G;
constexpr size_t OFF_VT = OFF_KN + (size_t)NPT * 2048 * 2;
constexpr size_t OFF_QR = OFF_VT + (size_t)2048 * NPT * 2;
constexpr size_t OFF_S = OFF_G;
constexpr size_t OFF_QLAT = OFF_WFF;
constexpr size_t OFF_CKVP = OFF_QLAT + (size_t)NTOK * 512 * 2;
constexpr size_t OFF_GA = OFF_G;
constexpr size_t OFF_OLAT = OFF_WD;
constexpr size_t OFF_POOLED = OFF_XN;
constexpr size_t OFF_MIXED = OFF_POOLED + (size_t)NTOK * 1024 * 2;
constexpr size_t OFF_P = OFF_WGU;
constexpr size_t OFF_MERGED = OFF_XN;
constexpr size_t OFF_QABS = OFF_WIN;
constexpr size_t OFF_WUKP = OFF_G + (size_t)84 * 1048576;
static_assert(OFF_WUKP >= OFF_QR + (size_t)NPT * 1024 * 2 && OFF_WUKP + (size_t)512 * 2048 * 2 <= OFF_G + SZ_G, "WUKP placement");
constexpr size_t OFF_SLABG = OFF_GATES;
constexpr size_t OFF_SLAB = OFF_GATES;
static_assert((size_t)8 * NST * DM * 4 <= (size_t)NTOK * 4096 * 2, "SLAB overflow");
static_assert(OFF_QR + (size_t)NPT * 1024 * 2 <= OFF_G + SZ_G, "G region overflow");
static_assert((size_t)16384 * 1056 * 4 <= SZ_G, "S overflow");
static_assert((size_t)1024 * 16 * 512 * 2 <= SZ_WD, "OLAT overflow");
static_assert((size_t)1024 * 16 * 640 * 2 <= (size_t)6400 * 2048 * 2, "QABS overflow");
static_assert((size_t)16384 * 1152 * 2 <= SZ_WGU, "P overflow");

constexpr size_t OUT_Y = 0;
constexpr size_t OUT_CKV_P = 18874368, OUT_KR_P = 23068672, OUT_POOL_P = 23592960, OUT_CKV_S = 23654400, OUT_KR_S = 24178688, OUT_POOL_S = 24244224;

struct Params {
    const float* in[26];
    float* out;
    unsigned char* ws;
    int ph_lo, ph_hi;
};

typedef __bf16 bf16x2_t __attribute__((ext_vector_type(2)));
typedef float f32x2_t __attribute__((ext_vector_type(2)));
DI unsigned cvt_pk_bf16(float lo, float hi) { const f32x2_t v = {lo, hi}; const bf16x2_t b = __builtin_convertvector(v, bf16x2_t); return __builtin_bit_cast(unsigned, b); }
DI float bf2f(unsigned short b) { return __uint_as_float(((unsigned)b) << 16); }
DI float bflo(unsigned w) { return __uint_as_float(w << 16); }
DI float bfhi(unsigned w) { return __uint_as_float(w & 0xffff0000u); }
DI int lane_id() { return (int)__builtin_amdgcn_mbcnt_hi(~0u, __builtin_amdgcn_mbcnt_lo(~0u, 0u)); }
#define TIDX (wv * 64 + lane_id())
DI float wave_sum(float v) {
#pragma unroll
    for (int o = 32; o > 0; o >>= 1) v += __shfl_xor(v, o);
    return v;
}
DI float wave_max(float v) {
#pragma unroll
    for (int o = 32; o > 0; o >>= 1) v = fmaxf(v, __shfl_xor(v, o));
    return v;
}
DI void rope_cs(int pos, int i, float& c, float& s) {
    const float inv = exp2f(-(float)i * 0.41524101186092029f);
    float rev = (float)pos * inv * 0.15915494309189535f;
    rev = rev - floorf(rev);
    s = __builtin_amdgcn_sinf(rev); c = __builtin_amdgcn_cosf(rev);
}
DI float silu_f(float g) { return g * __builtin_amdgcn_rcpf(1.0f + __builtin_amdgcn_exp2f(-1.4426950408889634f * g)); }
DI float sigmoid_f(float g) { return __builtin_amdgcn_rcpf(1.0f + __builtin_amdgcn_exp2f(-1.4426950408889634f * g)); }

namespace pg8 {
constexpr int BM = 256, BK = 64, HALF = 128, HTB = HALF * BK * 2, STAGE_BYTES = 8 * HTB, NXCD = 8, WGM = 8;
DI int lds_byte(int r, int c) { const int st = (r >> 4) * 2 + (c >> 5), rr = r & 15, cc = c & 31, ob = rr * 64 + cc * 2; return st * 1024 + (ob ^ (((ob >> 9) & 1) << 5)); }
DI void stage_rc(int b, int& R, int& C) { const int st = b / 1024, sb = b % 1024, swz = sb ^ (((sb >> 9) & 1) << 5); R = (st >> 1) * 16 + swz / 64; C = (st & 1) * 32 + (swz % 64) / 2; }
DI int perm32(int rho) { const int n = rho >> 4, i = rho & 15; return 8 * (i >> 2) + 4 * n + (i & 3); }

struct Unit { int pm, pn, bz, kt0, nkt, part; };
struct Gemm {
    const char* A; const char* B;
    int lda, ldb, K;
    int nM, nN, nB;
    long long a_ts, b_ts;
    long long a_bs, b_bs;
    int rot;
    int u0, u1, boff, nblk;
    int split;
};
DI void map_unit(int wgid, int nM, int nN, int nwg, int& pm, int& pn) {
    { const int q = nwg / NXCD, r = nwg % NXCD, xcd = wgid % NXCD, off = wgid / NXCD; wgid = (xcd < r ? xcd * (q + 1) : r * (q + 1) + (xcd - r) * q) + off; }
    const int nig = WGM * nN, gid = wgid / nig, fm = gid * WGM, gsz = (nM - fm) < WGM ? (nM - fm) : WGM;
    pm = fm + ((wgid % nig) % gsz); pn = (wgid % nig) / gsz;
}
struct Order {
    int nM, nN, nB, nwg, G, c, split, ntk, u0, u1;
    DI void init(const Gemm& g) { nM = g.nM; nN = g.nN; nB = g.nB; split = g.split; ntk = g.K / BK; if (split == 1) nM = 32; nwg = nM * nN * nB; u0 = 0; u1 = 0x7fffffff;
        if (g.nblk > 0) { u0 = g.u0; u1 = g.u1; G = g.nblk; c = (int)blockIdx.x - g.boff; if (c < 0 || c >= G) { u0 = 0; u1 = 0; c = 0; } return; } G = gridDim.x; c = (int)((blockIdx.x + (unsigned)g.rot) % gridDim.x); }
    DI bool next(int i, Unit& u) const {
        long L = (long)u0 + (long)i * G + c; if (L >= u1) return false;
        u.kt0 = 0; u.nkt = ntk; u.part = -1;
        if (split == 1 && L >= nwg) {
            L -= nwg; if (L >= 256) return false;
            const int kp = (int)(L & 7), t = (int)(L >> 3); u.pm = 32 + (t & 3); u.pn = t >> 2; u.bz = 0; u.part = kp;
            const int P = ntk >> 1, base = P >> 3, rem = P & 7; u.kt0 = 2 * (kp * base + (kp < rem ? kp : rem)); u.nkt = 2 * (base + (kp < rem ? 1 : 0));
            return true;
        }
        if (split == 2) {
            const int full = (nwg / G) * G, left = nwg - full;
            if (L >= full) { const int qd = (int)L - full; if (qd >= 4 * left) return false;
                map_unit(full + (qd >> 2), nM, nN, nwg, u.pm, u.pn); u.bz = qd >> 2; u.part = qd & 3; u.nkt = ntk >> 2; u.kt0 = u.part * u.nkt; return true; }
        }
        if (L >= nwg) return false;
        int wgid = (int)L;
        if (nB == 1) {
            map_unit(wgid, nM, nN, nwg, u.pm, u.pn); u.bz = 0;
        } else {
            const int per = nM * nN; u.bz = wgid / per; const int rem = wgid - u.bz * per; u.pm = rem % nM; u.pn = rem / nM;
        }
        return true;
    }
};

template <class Epi>
DI void gemm_phase(LAS unsigned char* lds, const Gemm g, const Epi& E, const int wv) {
    const int wid = wv, lane = lane_id(), tid = wid * 64 + lane, wr = wid >> 2, wc = wid & 3, fr = lane & 15, fq = lane >> 4;
    Order S; S.init(g);
    unsigned voffA[2], voffB[2];
#pragma unroll
    for (int i = 0; i < 2; ++i) { int R, C; stage_rc(tid * 16 + i * 8192, R, C); const int Rb = Epi::PERM ? ((R & ~31) + perm32(R & 31)) : R;
        voffA[i] = (unsigned)(R * g.lda + C) * 2u; voffB[i] = (unsigned)(Rb * g.ldb + C) * 2u; }
    const size_t kstep = (size_t)(BK * 2);
    const size_t hstepA = (size_t)HALF * g.lda * 2, hstepB = (size_t)HALF * g.ldb * 2;
    const unsigned ldsw = (unsigned)wid * 1024u;
    const int aoff = lds_byte(wr * 64 + fr, fq * 8), boff = lds_byte(wc * 32 + fr, fq * 8);
#define PG8_SA(b, h) (((b) * 2 + (h)) * HTB)
#define PG8_SB(b, h) ((4 + (b) * 2 + (h)) * HTB)
#define PG8_STAGE(bufoff, gbase, voff) do { _Pragma("unroll") for (int _i = 0; _i < 2; ++_i) \
        __builtin_amdgcn_global_load_lds((const unsigned*)((const char*)(gbase) + (voff)[_i]), (LAS unsigned*)(lds + (bufoff) + ldsw + _i * 8192), 16, 0, 0); } while (0)
#define PG8_LDA(dst, b, h) do { _Pragma("unroll") for (int m = 0; m < 4; ++m) _Pragma("unroll") for (int k = 0; k < 2; ++k) dst[m][k] = *(const LAS bf16x8*)(lds + PG8_SA(b, h) + aoff + m * 2048 + k * 1024); } while (0)
#define PG8_LDB(dst, b, h) do { _Pragma("unroll") for (int n = 0; n < 2; ++n) _Pragma("unroll") for (int k = 0; k < 2; ++k) dst[n][k] = *(const LAS bf16x8*)(lds + PG8_SB(b, h) + boff + n * 2048 + k * 1024); } while (0)
#define PG8_MMA(ai, bj, At, Bt) do { __builtin_amdgcn_s_setprio(1); _Pragma("unroll") for (int m = 0; m < 4; ++m) _Pragma("unroll") for (int n = 0; n < 2; ++n) _Pragma("unroll") for (int k = 0; k < 2; ++k) \
        acc[ai][bj][m][n] = __builtin_amdgcn_mfma_f32_16x16x32_bf16(Bt[n][k], At[m][k], acc[ai][bj][m][n], 0, 0, 0); __builtin_amdgcn_s_setprio(0); } while (0)
#define PG8_WAIT_V(n) asm volatile("s_waitcnt vmcnt(" #n ")" ::: "memory")
#define PG8_WAIT_L(n) asm volatile("s_waitcnt lgkmcnt(" #n ")" ::: "memory")
#define PG8_BAR __builtin_amdgcn_s_barrier()
#define PG8_SCHED __builtin_amdgcn_sched_barrier(0)
    Unit cur, nxt; int ui = 0;
    if (!S.next(0, cur)) return;
    f32x4 acc[2][2][4][2];
#pragma unroll
    for (int a = 0; a < 2; ++a)
#pragma unroll
        for (int b = 0; b < 2; ++b)
#pragma unroll
            for (int m = 0; m < 4; ++m)
#pragma unroll
                for (int n = 0; n < 2; ++n) acc[a][b][m][n] = (f32x4){0.f, 0.f, 0.f, 0.f};
    bf16x8 At[4][2], B0[2][2], B1[2][2];
    const char* cA = g.A + (size_t)cur.bz * g.a_bs + (size_t)cur.pm * g.a_ts + (size_t)cur.kt0 * kstep; const char* cB = g.B + (size_t)cur.bz * g.b_bs + (size_t)cur.pn * g.b_ts + (size_t)cur.kt0 * kstep;
    PG8_STAGE(PG8_SB(0, 0), cB, voffB); PG8_STAGE(PG8_SA(0, 0), cA, voffA); PG8_STAGE(PG8_SB(0, 1), cB + hstepB, voffB); PG8_STAGE(PG8_SA(0, 1), cA + hstepA, voffA);
    if (wr == 1) PG8_BAR;
    PG8_WAIT_V(4); PG8_BAR;
    PG8_STAGE(PG8_SB(1, 0), cB + kstep, voffB); PG8_STAGE(PG8_SA(1, 0), cA + kstep, voffA); PG8_STAGE(PG8_SB(1, 1), cB + hstepB + kstep, voffB);
    PG8_WAIT_V(6); PG8_BAR;
    for (;;) {
        const bool has_next = S.next(ui + 1, nxt);
        const char* nA = has_next ? g.A + (size_t)nxt.bz * g.a_bs + (size_t)nxt.pm * g.a_ts + (size_t)nxt.kt0 * kstep : cA; const char* nB = has_next ? g.B + (size_t)nxt.bz * g.b_bs + (size_t)nxt.pn * g.b_ts + (size_t)nxt.kt0 * kstep : cB;
        const int nt = cur.nkt;
        for (int t = 0; t < nt; t += 2) {
            const bool last = (t == nt - 2);
            const char* a1 = cA + (size_t)(t + 1) * kstep;
            const char* a2 = last ? nA : cA + (size_t)(t + 2) * kstep; const char* b2 = last ? nB : cB + (size_t)(t + 2) * kstep;
            const char* a3 = a2 + kstep; const char* b3 = b2 + kstep;
            PG8_LDB(B0, 0, 0); PG8_SCHED; PG8_LDA(At, 0, 0); PG8_STAGE(PG8_SA(1, 1), a1 + hstepA, voffA);
            PG8_WAIT_L(8); PG8_BAR; PG8_WAIT_L(0); PG8_MMA(0, 0, At, B0); PG8_BAR; PG8_SCHED;
            PG8_LDB(B1, 0, 1); PG8_STAGE(PG8_SB(0, 0), b2, voffB);
            PG8_BAR; PG8_WAIT_L(0); PG8_MMA(0, 1, At, B1); PG8_BAR;
            PG8_LDA(At, 0, 1); PG8_STAGE(PG8_SA(0, 0), a2, voffA);
            PG8_BAR; PG8_WAIT_L(0); PG8_MMA(1, 0, At, B0); PG8_BAR; PG8_SCHED;
            PG8_STAGE(PG8_SB(0, 1), b2 + hstepB, voffB);
            PG8_WAIT_V(6); PG8_BAR; PG8_MMA(1, 1, At, B1); PG8_BAR;
            PG8_LDB(B0, 1, 0); PG8_SCHED; PG8_LDA(At, 1, 0); PG8_STAGE(PG8_SA(0, 1), a2 + hstepA, voffA);
            PG8_WAIT_L(8); PG8_BAR; PG8_WAIT_L(0); PG8_MMA(0, 0, At, B0); PG8_BAR; PG8_SCHED;
            PG8_LDB(B1, 1, 1); PG8_STAGE(PG8_SB(1, 0), b3, voffB);
            PG8_BAR; PG8_WAIT_L(0); PG8_MMA(0, 1, At, B1); PG8_BAR;
            PG8_LDA(At, 1, 1); PG8_STAGE(PG8_SA(1, 0), a3, voffA);
            PG8_BAR; PG8_WAIT_L(0); PG8_MMA(1, 0, At, B0); PG8_BAR; PG8_SCHED;
            PG8_STAGE(PG8_SB(1, 1), b3 + hstepB, voffB);
            PG8_WAIT_V(6); PG8_BAR; PG8_MMA(1, 1, At, B1); PG8_BAR;
        }
        E(acc, cur, wr, wc, fr, fq);
        if (!has_next) break;
#pragma unroll
        for (int a = 0; a < 2; ++a)
#pragma unroll
            for (int b = 0; b < 2; ++b)
#pragma unroll
                for (int m = 0; m < 4; ++m)
#pragma unroll
                    for (int n = 0; n < 2; ++n) acc[a][b][m][n] = (f32x4){0.f, 0.f, 0.f, 0.f};
        cur = nxt; cA = nA; cB = nB; ++ui;
    }
    PG8_WAIT_V(0);
    if (wr == 0) PG8_BAR;
    PG8_BAR;
#undef PG8_SA
#undef PG8_SB
#undef PG8_STAGE
#undef PG8_LDA
#undef PG8_LDB
#undef PG8_MMA
#undef PG8_WAIT_V
#undef PG8_WAIT_L
#undef PG8_BAR
#undef PG8_SCHED
}

typedef f32x4 Acc[2][2][4][2];
#define EPI_ROWS  _Pragma("unroll") for (int ai = 0; ai < 2; ++ai) _Pragma("unroll") for (int m = 0; m < 4; ++m)

struct EpiSwiglu {
    static constexpr bool PERM = true;
    bf16_t* G; float* slab;
    DI void operator()(const Acc& acc, const Unit& u, int wr, int wc, int fr, int fq) const {
        if (u.part >= 0) {
            bf16_t* sp = (bf16_t*)slab + ((size_t)(u.bz * 4 + u.part) * 32 * 512 + (size_t)((wr * 4 + wc) * 64 + fq * 16 + fr)) * 4;
#pragma unroll
            for (int ai = 0; ai < 2; ++ai)
#pragma unroll
                for (int bj = 0; bj < 2; ++bj)
#pragma unroll
                    for (int m = 0; m < 4; ++m)
#pragma unroll
                        for (int n = 0; n < 2; ++n) { const f32x4 t = acc[ai][bj][m][n]; u32x2 w; w.x = cvt_pk_bf16(t[0], t[1]); w.y = cvt_pk_bf16(t[2], t[3]);
                            *(u32x2*)(sp + (size_t)(((ai * 2 + bj) * 4 + m) * 2 + n) * 2048) = w; }
            return;
        }
        const int row0 = u.pm * BM + wr * 64 + fr, col0 = u.pn * 128 + wc * 32 + 8 * fq;
        EPI_ROWS { bf16_t* rp = G + (size_t)(row0 + ai * HALF + m * 16) * DFF + col0;
            const f32x4 g0 = acc[ai][0][m][0], g1 = acc[ai][0][m][1], u0 = acc[ai][1][m][0], u1 = acc[ai][1][m][1];
            u32x4 w; w.x = cvt_pk_bf16(silu_f(g0[0]) * u0[0], silu_f(g0[1]) * u0[1]); w.y = cvt_pk_bf16(silu_f(g0[2]) * u0[2], silu_f(g0[3]) * u0[3]);
            w.z = cvt_pk_bf16(silu_f(g1[0]) * u1[0], silu_f(g1[1]) * u1[1]); w.w = cvt_pk_bf16(silu_f(g1[2]) * u1[2], silu_f(g1[3]) * u1[3]);
            *(u32x4*)rp = w; }
    }
};
struct EpiResid {
    static constexpr bool PERM = false;
    float* out; const float* resP; const float* resS; float scale; float* slab;
    const bf16_t* resB; bf16_t* outB;
    DI void operator()(const Acc& acc, const Unit& u, int wr, int wc, int fr, int fq) const {
        const int row0 = u.pm * BM + wr * 64 + fr, col0 = u.pn * BM + wc * 32 + 4 * fq;
        if (u.part >= 0) {
            EPI_ROWS { bf16_t* op = (bf16_t*)slab + ((size_t)u.part * NST + (size_t)(row0 + ai * HALF + m * 16 - NPT)) * DM + col0;
#pragma unroll
                for (int bj = 0; bj < 2; ++bj)
#pragma unroll
                    for (int n = 0; n < 2; ++n) { const f32x4 t = acc[ai][bj][m][n] * scale; u32x2 w; w.x = cvt_pk_bf16(t[0], t[1]); w.y = cvt_pk_bf16(t[2], t[3]); *(u32x2*)(op + bj * HALF + n * 16) = w; } }
            return;
        }
        const float* rb = (u.pm * BM < NPT ? resP : resS - (size_t)NPT * DM) + col0; float* ob = out + col0;
#define ER_ROW(b, mm) ((size_t)(row0 + ((b) >> 1) * HALF + (2 * ((b) & 1) + (mm)) * 16) * DM)
#define ER_LD(R, b) do { _Pragma("unroll") for (int mm = 0; mm < 2; ++mm) _Pragma("unroll") for (int bj = 0; bj < 2; ++bj) _Pragma("unroll") for (int n = 0; n < 2; ++n) { \
            if (resB != nullptr) { const u32x2 w_ = *(const u32x2*)(resB + ER_ROW(b, mm) + col0 + bj * HALF + n * 16); R[mm][bj][n] = (f32x4){__uint_as_float(w_.x), __uint_as_float(w_.y), 0.f, 0.f}; } \
            else R[mm][bj][n] = *(const f32x4*)(rb + ER_ROW(b, mm) + bj * HALF + n * 16); } } while (0)
#define ER_ST(R, b) do { _Pragma("unroll") for (int mm = 0; mm < 2; ++mm) _Pragma("unroll") for (int bj = 0; bj < 2; ++bj) _Pragma("unroll") for (int n = 0; n < 2; ++n) { \
            f32x4 r_ = R[mm][bj][n]; if (resB != nullptr) { const unsigned w0_ = __float_as_uint(r_[0]), w1_ = __float_as_uint(r_[1]); r_ = (f32x4){bflo(w0_), bfhi(w0_), bflo(w1_), bfhi(w1_)}; } \
            const f32x4 hv_ = r_ + acc[(b) >> 1][bj][2 * ((b) & 1) + mm][n] * scale; \
            if (outB != nullptr) { u32x2 w_; w_.x = cvt_pk_bf16(hv_[0], hv_[1]); w_.y = cvt_pk_bf16(hv_[2], hv_[3]); *(u32x2*)(outB + ER_ROW(b, mm) + col0 + bj * HALF + n * 16) = w_; } \
            else *(f32x4*)(ob + ER_ROW(b, mm) + bj * HALF + n * 16) = hv_; } } while (0)
        f32x4 ra[2][2][2], rc[2][2][2];
        ER_LD(ra, 0); ER_LD(rc, 1); ER_ST(ra, 0); ER_LD(ra, 2); ER_ST(rc, 1); ER_LD(rc, 3); ER_ST(ra, 2); ER_ST(rc, 3);
#undef ER_ROW
#undef ER_LD
#undef ER_ST
    }
};
struct EpiBf16 {
    static constexpr bool PERM = true;
    bf16_t* O; int ld; long long bs; float scale; int half_only;
    DI void operator()(const Acc& acc, const Unit& u, int wr, int wc, int fr, int fq) const {
        const int row0 = u.pm * BM + wr * 64 + fr, col0 = u.pn * (half_only ? 128 : BM) + wc * 32 + 8 * fq;
        bf16_t* base = O + (size_t)u.bz * bs;
        EPI_ROWS { bf16_t* rp = base + (size_t)(row0 + ai * HALF + m * 16) * ld + col0;
#pragma unroll
            for (int bj = 0; bj < 2; ++bj) { if (bj == 1 && half_only) continue;
                const f32x4 v0 = acc[ai][bj][m][0] * scale, v1 = acc[ai][bj][m][1] * scale;
                u32x4 w; w.x = cvt_pk_bf16(v0[0], v0[1]); w.y = cvt_pk_bf16(v0[2], v0[3]); w.z = cvt_pk_bf16(v1[0], v1[1]); w.w = cvt_pk_bf16(v1[2], v1[3]);
                *(u32x4*)(rp + bj * HALF) = w; } }
    }
};
struct EpiScore {
    static constexpr bool PERM = false;
    _Float16* S;
    DI void operator()(const Acc& acc, const Unit& u, int wr, int wc, int fr, int fq) const {
        const int row0 = u.bz * 512 + u.pm * BM + wr * 64 + fr, col0 = u.pn * BM + wc * 32 + 4 * fq;
        EPI_ROWS { _Float16* op = S + (size_t)(row0 + ai * HALF + m * 16) * 1056 + col0;
#pragma unroll
            for (int bj = 0; bj < 2; ++bj)
#pragma unroll
                for (int n = 0; n < 2; ++n) { if (col0 + bj * HALF + n * 16 < 1056) *(u32x2*)(op + bj * HALF + n * 16) = __builtin_bit_cast(u32x2, __builtin_convertvector(acc[ai][bj][m][n], f16x4)); } }
    }
};
struct EpiWin {
    static constexpr bool PERM = true;
    float* Z; float* QLR; float* CKR; bf16_t* GATES; bf16_t* KRB; float* outKrP; float* outKrS;
    DI void operator()(const Acc& acc, const Unit& u, int wr, int wc, int fr, int fq) const {
        const int row0 = u.pm * BM + wr * 64 + fr, cw = wc * 32 + 8 * fq;
        if (u.pn < 8) {
            float* base; int ld, c0;
            if (u.pn < 4) { base = Z; ld = 1024; c0 = u.pn * 256; } else if (u.pn < 6) { base = QLR; ld = 512; c0 = (u.pn - 4) * 256; } else { base = CKR; ld = 512; c0 = (u.pn - 6) * 256; }
            EPI_ROWS { float* op = base + (size_t)(row0 + ai * HALF + m * 16) * ld + c0 + cw;
#pragma unroll
                for (int bj = 0; bj < 2; ++bj) { *(f32x4*)(op + bj * HALF) = acc[ai][bj][m][0]; *(f32x4*)(op + bj * HALF + 4) = acc[ai][bj][m][1]; } }
        } else if (u.pn < 24) {
            const int c0 = (u.pn - 8) * 256 + cw;
            EPI_ROWS { bf16_t* op = GATES + (size_t)(row0 + ai * HALF + m * 16) * 4096 + c0;
#pragma unroll
                for (int bj = 0; bj < 2; ++bj) { const f32x4 v0 = acc[ai][bj][m][0], v1 = acc[ai][bj][m][1];
                    u32x4 w; w.x = cvt_pk_bf16(sigmoid_f(v0[0]), sigmoid_f(v0[1])); w.y = cvt_pk_bf16(sigmoid_f(v0[2]), sigmoid_f(v0[3]));
                    w.z = cvt_pk_bf16(sigmoid_f(v1[0]), sigmoid_f(v1[1])); w.w = cvt_pk_bf16(sigmoid_f(v1[2]), sigmoid_f(v1[3]));
                    *(u32x4*)(op + bj * HALF) = w; } }
        } else if (wc == 0) {
            EPI_ROWS { const int row = row0 + ai * HALF + m * 16;
                const int pos = row < NPT ? (row & 2047) : 1024 + ((row - NPT) & 31);
                float* of = row < NPT ? outKrP + (size_t)row * 64 : outKrS + (size_t)(row - NPT) * 64;
                bf16_t* ob = KRB + (size_t)row * 64;
                float o1[8], o2[8];
#pragma unroll
                for (int n = 0; n < 2; ++n)
#pragma unroll
                    for (int j = 0; j < 4; ++j) { float c, s; rope_cs(pos, 8 * fq + 4 * n + j, c, s); const float x1 = acc[ai][0][m][n][j], x2 = acc[ai][1][m][n][j];
                        o1[4 * n + j] = x1 * c - x2 * s; o2[4 * n + j] = x2 * c + x1 * s; }
                *(f32x4*)(of + 8 * fq) = (f32x4){o1[0], o1[1], o1[2], o1[3]}; *(f32x4*)(of + 8 * fq + 4) = (f32x4){o1[4], o1[5], o1[6], o1[7]};
                *(f32x4*)(of + 32 + 8 * fq) = (f32x4){o2[0], o2[1], o2[2], o2[3]}; *(f32x4*)(of + 32 + 8 * fq + 4) = (f32x4){o2[4], o2[5], o2[6], o2[7]};
                u32x4 w1, w2; w1.x = cvt_pk_bf16(o1[0], o1[1]); w1.y = cvt_pk_bf16(o1[2], o1[3]); w1.z = cvt_pk_bf16(o1[4], o1[5]); w1.w = cvt_pk_bf16(o1[6], o1[7]);
                w2.x = cvt_pk_bf16(o2[0], o2[1]); w2.y = cvt_pk_bf16(o2[2], o2[3]); w2.z = cvt_pk_bf16(o2[4], o2[5]); w2.w = cvt_pk_bf16(o2[6], o2[7]);
                *(u32x4*)(ob + 8 * fq) = w1; *(u32x4*)(ob + 32 + 8 * fq) = w2; }
        }
    }
};
struct EpiQ {
    static constexpr bool PERM = true;
    bf16_t* QN; bf16_t* QR; bf16_t* QABS;
    DI void operator()(const Acc& acc, const Unit& u, int wr, int wc, int fr, int fq) const {
        const int row0 = u.pm * BM + wr * 64 + fr;
        if (u.pn < 8) {
            const int col0 = u.pn * BM + wc * 32 + 8 * fq;
            EPI_ROWS { bf16_t* rp = QN + (size_t)(row0 + ai * HALF + m * 16) * 2048 + col0;
#pragma unroll
                for (int bj = 0; bj < 2; ++bj) { const f32x4 v0 = acc[ai][bj][m][0] * QSCALE, v1 = acc[ai][bj][m][1] * QSCALE;
                    u32x4 w; w.x = cvt_pk_bf16(v0[0], v0[1]); w.y = cvt_pk_bf16(v0[2], v0[3]); w.z = cvt_pk_bf16(v1[0], v1[1]); w.w = cvt_pk_bf16(v1[2], v1[3]);
                    *(u32x4*)(rp + bj * HALF) = w; } }
        } else {
            const int head = 4 * (u.pn - 8) + wc;
            EPI_ROWS { const int row = row0 + ai * HALF + m * 16;
                const int pos = row < NPT ? (row & 2047) : 1024 + ((row - NPT) & 31);
                float o1[8], o2[8];
#pragma unroll
                for (int n = 0; n < 2; ++n)
#pragma unroll
                    for (int j = 0; j < 4; ++j) { float c, s; rope_cs(pos, 8 * fq + 4 * n + j, c, s); const float x1 = acc[ai][0][m][n][j] * QSCALE, x2 = acc[ai][1][m][n][j] * QSCALE;
                        o1[4 * n + j] = x1 * c - x2 * s; o2[4 * n + j] = x2 * c + x1 * s; }
                u32x4 w1, w2; w1.x = cvt_pk_bf16(o1[0], o1[1]); w1.y = cvt_pk_bf16(o1[2], o1[3]); w1.z = cvt_pk_bf16(o1[4], o1[5]); w1.w = cvt_pk_bf16(o1[6], o1[7]);
                w2.x = cvt_pk_bf16(o2[0], o2[1]); w2.y = cvt_pk_bf16(o2[2], o2[3]); w2.z = cvt_pk_bf16(o2[4], o2[5]); w2.w = cvt_pk_bf16(o2[6], o2[7]);
                if (row < NPT) { bf16_t* ob = QR + (size_t)row * 1024 + head * 64; *(u32x4*)(ob + 8 * fq) = w1; *(u32x4*)(ob + 32 + 8 * fq) = w2; }
                else { bf16_t* ob = QABS + ((size_t)(row - NPT) * 16 + head) * 640 + 512; const u32x4 z = (u32x4){0u, 0u, 0u, 0u};
                    *(u32x4*)(ob + 8 * fq) = w1; *(u32x4*)(ob + 32 + 8 * fq) = w2; *(u32x4*)(ob + 64 + 8 * fq) = z; *(u32x4*)(ob + 96 + 8 * fq) = z; } }
        }
    }
};
struct EpiPoolMix {
    static constexpr bool PERM = true;
    bf16_t* MIXED; const float* pscale;
    DI void operator()(const Acc& acc, const Unit& u, int wr, int wc, int fr, int fq) const {
        const int row0 = u.pm * BM + wr * 64 + fr, col0 = u.bz * 256 + wc * 32 + 8 * fq;
        f32x4 sc[2][2];
#pragma unroll
        for (int bj = 0; bj < 2; ++bj) { sc[bj][0] = *(const f32x4*)(pscale + col0 + bj * HALF); sc[bj][1] = *(const f32x4*)(pscale + col0 + bj * HALF + 4); }
        EPI_ROWS { bf16_t* rp = MIXED + (size_t)(row0 + ai * HALF + m * 16) * 1024 + col0;
#pragma unroll
            for (int bj = 0; bj < 2; ++bj) { const f32x4 v0 = acc[ai][bj][m][0] * sc[bj][0], v1 = acc[ai][bj][m][1] * sc[bj][1];
                u32x4 w; w.x = cvt_pk_bf16(v0[0], v0[1]); w.y = cvt_pk_bf16(v0[2], v0[3]); w.z = cvt_pk_bf16(v1[0], v1[1]); w.w = cvt_pk_bf16(v1[2], v1[3]);
                *(u32x4*)(rp + bj * HALF) = w; } }
    }
};
struct EpiGate {
    static constexpr bool PERM = true;
    bf16_t* OUT; const bf16_t* GATES; const bf16_t* ADD; int goff; int mode;
    DI void operator()(const Acc& acc, const Unit& u, int wr, int wc, int fr, int fq) const {
        const int row0 = u.pm * BM + wr * 64 + fr, col0 = u.pn * BM + wc * 32 + 8 * fq;
#define EG_ROW(b, mm) ((size_t)(row0 + ((b) >> 1) * HALF + (2 * ((b) & 1) + (mm)) * 16))
#define EG_LD(GW, AW, b) do { _Pragma("unroll") for (int mm = 0; mm < 2; ++mm) _Pragma("unroll") for (int bj = 0; bj < 2; ++bj) { const int c = col0 + bj * HALF; \
            GW[mm][bj] = *(const u32x4*)(GATES + EG_ROW(b, mm) * 4096 + goff + c); AW[mm][bj] = (u32x4){0u, 0u, 0u, 0u}; if (mode) AW[mm][bj] = *(const u32x4*)(ADD + EG_ROW(b, mm) * 2048 + c); } } while (0)
#define EG_ST(GW, AW, b) do { _Pragma("unroll") for (int mm = 0; mm < 2; ++mm) _Pragma("unroll") for (int bj = 0; bj < 2; ++bj) { const int c = col0 + bj * HALF; \
            const u32x4 gw = GW[mm][bj], aw = AW[mm][bj]; const f32x4 a0 = acc[(b) >> 1][bj][2 * ((b) & 1) + mm][0], a1 = acc[(b) >> 1][bj][2 * ((b) & 1) + mm][1]; \
            u32x4 w; w.x = cvt_pk_bf16(bflo(aw.x) + bflo(gw.x) * a0[0], bfhi(aw.x) + bfhi(gw.x) * a0[1]); w.y = cvt_pk_bf16(bflo(aw.y) + bflo(gw.y) * a0[2], bfhi(aw.y) + bfhi(gw.y) * a0[3]); \
            w.z = cvt_pk_bf16(bflo(aw.z) + bflo(gw.z) * a1[0], bfhi(aw.z) + bfhi(gw.z) * a1[1]); w.w = cvt_pk_bf16(bflo(aw.w) + bflo(gw.w) * a1[2], bfhi(aw.w) + bfhi(gw.w) * a1[3]); \
            *(u32x4*)(OUT + EG_ROW(b, mm) * 2048 + c) = w; } } while (0)
        u32x4 ga[2][2], aa[2][2], gb[2][2], ab[2][2];
        EG_LD(ga, aa, 0); EG_LD(gb, ab, 1); EG_ST(ga, aa, 0); EG_LD(ga, aa, 2); EG_ST(gb, ab, 1); EG_LD(gb, ab, 3); EG_ST(ga, aa, 2); EG_ST(gb, ab, 3);
#undef EG_ROW
#undef EG_LD
#undef EG_ST
    }
};
}

template <int MAP> DI int maprow(int n) {
    if (MAP == 1) return 256 * (n >> 7) + (n & 127);
    if (MAP == 2) return 256 * (n >> 7) + 128 + (n & 127);
    if (MAP == 3) { if (n < 2048) return n; if (n < 2112) { const int i = n - 2048; return 6144 + (i >> 5) * 128 + (i & 31); } return n - 64; }
    if (MAP == 4) { const int h = n / 192, d = n - h * 192; if (d < 128) return h * 128 + d; const int i = d - 128; return 256 * (8 + (h >> 2)) + (i >> 5) * 128 + (h & 3) * 32 + (i & 31); }
    return n;
}
template <int MAP> DI void convT(const float* __restrict__ src, int ldsrc, int K, int N, bf16_t* __restrict__ dst, int ldd, float* sm, int blk, int nblk, const int wv) {
    const int tid = TIDX, ntk = K >> 7, ntn = N >> 6, ntile = ntk * ntn;
    const int rr = tid >> 4, c4 = (tid & 15) * 4;
    f32x4 v[4], n1[4], n2[4];
#define CT_LOAD(dstv, t) do { const int kt_ = (t) % ntk, nt_ = (t) / ntk; const float* sp_ = src + (size_t)(kt_ * 128 + rr) * ldsrc + nt_ * 64 + c4; \
        _Pragma("unroll") for (int q = 0; q < 4; ++q) dstv[q] = *(const f32x4*)(sp_ + (size_t)(32 * q) * ldsrc); } while (0)
    int tile = blk;
    if (tile < ntile) CT_LOAD(v, tile);
    if (tile + nblk < ntile) CT_LOAD(n1, tile + nblk);
    for (; tile < ntile; tile += nblk) {
        const int kt = tile % ntk, nt = tile / ntk;
        if (tile + 2 * nblk < ntile) CT_LOAD(n2, tile + 2 * nblk);
#pragma unroll
        for (int q = 0; q < 4; ++q)
#pragma unroll
            for (int e = 0; e < 4; ++e) sm[(c4 + e) * 132 + rr + 32 * q] = v[q][e];
        __syncthreads();
#pragma unroll
        for (int u = 0; u < 2; ++u) { const int id = tid + 512 * u, wn = id >> 4, k8 = (id & 15) * 8;
            const f32x4 a = *(const f32x4*)(sm + wn * 132 + k8), b = *(const f32x4*)(sm + wn * 132 + k8 + 4);
            u32x4 w; w.x = cvt_pk_bf16(a[0], a[1]); w.y = cvt_pk_bf16(a[2], a[3]); w.z = cvt_pk_bf16(b[0], b[1]); w.w = cvt_pk_bf16(b[2], b[3]);
            *(u32x4*)(dst + (size_t)maprow<MAP>(nt * 64 + wn) * ldd + kt * 128 + k8) = w; }
        __syncthreads();
#pragma unroll
        for (int q = 0; q < 4; ++q) { v[q] = n1[q]; n1[q] = n2[q]; }
    }
#undef CT_LOAD
}
DI void rmsnorm_rows_bf16(const float* srcP, const float* srcS, const float* __restrict__ gain, bf16_t* dst, const float* slab, float* hS, const int wv, const bf16_t* srcPB = nullptr) {
    const int lane = lane_id(), gw = blockIdx.x * 8 + wv, nw = gridDim.x * 8;
    for (int r = gw; r < NTOK; r += nw) {
        const float* sp = (r < NPT ? srcP + (size_t)r * DM : srcS + (size_t)(r - NPT) * DM);
        f32x4 v[8]; float ss = 0.f;
        if (srcPB != nullptr && r < NPT) {
#pragma unroll
            for (int i = 0; i < 8; ++i) { const u32x2 w = *(const u32x2*)(srcPB + (size_t)r * DM + i * 256 + lane * 4); v[i] = (f32x4){bflo(w.x), bfhi(w.x), bflo(w.y), bfhi(w.y)}; }
        } else {
#pragma unroll
            for (int i = 0; i < 8; ++i) v[i] = *(const f32x4*)(sp + i * 256 + lane * 4);
        }
        if (slab != nullptr && r >= NPT) {
#pragma unroll
            for (int sidx = 0; sidx < 8; ++sidx) { const bf16_t* sl = (const bf16_t*)slab + ((size_t)sidx * NST + (r - NPT)) * DM;
#pragma unroll
                for (int i = 0; i < 8; ++i) { const u32x2 w = *(const u32x2*)(sl + i * 256 + lane * 4); v[i] += (f32x4){bflo(w.x), bfhi(w.x), bflo(w.y), bfhi(w.y)}; } }
#pragma unroll
            for (int i = 0; i < 8; ++i) *(f32x4*)(hS + (size_t)(r - NPT) * DM + i * 256 + lane * 4) = v[i];
        }
#pragma unroll
        for (int i = 0; i < 8; ++i) ss += v[i][0] * v[i][0] + v[i][1] * v[i][1] + v[i][2] * v[i][2] + v[i][3] * v[i][3];
        ss = wave_sum(ss); const float rstd = rsqrtf(ss * (1.0f / 2048.0f) + 1e-6f);
#pragma unroll
        for (int i = 0; i < 8; ++i) { const f32x4 g = *(const f32x4*)(gain + i * 256 + lane * 4);
            u32x2 w; w.x = cvt_pk_bf16(v[i][0] * rstd * g[0], v[i][1] * rstd * g[1]); w.y = cvt_pk_bf16(v[i][2] * rstd * g[2], v[i][3] * rstd * g[3]);
            *(u32x2*)(dst + (size_t)r * DM + i * 256 + lane * 4) = w; }
    }
}
DI void convert_ffn_weights(const Params& p, unsigned char* ws, int layer, float* sm, const int bi, const int nb, const int wv, const int which = 3) {
    const float* wg = p.in[layer ? 22 : 6]; const float* wu = p.in[layer ? 23 : 7]; const float* wd = p.in[layer ? 24 : 8];
    if (which & 1) { convT<1>(wg, DFF, 2048, DFF, (bf16_t*)(ws + OFF_WGU), 2048, sm, bi, nb, wv);
        convT<2>(wu, DFF, 2048, DFF, (bf16_t*)(ws + OFF_WGU), 2048, sm, bi, nb, wv); }
    if (which & 2) convT<0>(wd, 2048, DFF, 2048, (bf16_t*)(ws + OFF_WD), DFF, sm, bi, nb, wv);
}

DI void convert_other_weights(const Params& p, unsigned char* ws, float* smf, const int bi, const int nb, const int wv) {
            convT<3>(p.in[10], 6208, 2048, 6208, (bf16_t*)(ws + OFF_WIN), 2048, smf, bi, nb, wv);
            convT<4>(p.in[13], 3072, 512, 3072, (bf16_t*)(ws + OFF_WUQ), 512, smf, (bi + 64) % nb, nb, wv);
            convT<0>(p.in[14], 2048, 512, 2048, (bf16_t*)(ws + OFF_WUKT), 512, smf, (bi + 192) % nb, nb, wv);
            convT<0>(p.in[15], 2048, 512, 2048, (bf16_t*)(ws + OFF_WUVT), 512, smf, bi, nb, wv);
            convT<0>(p.in[16], 2048, 2048, 2048, (bf16_t*)(ws + OFF_WOA), 2048, smf, bi, nb, wv);
            for (int g = 0; g < 4; ++g) convT<0>(p.in[17] + (size_t)g * 65536, 256, 256, 256, (bf16_t*)(ws + OFF_WPOOL) + (size_t)g * 65536, 256, smf, (bi + 16 * g) % nb, nb, wv);
            convT<0>(p.in[19], 2048, 1024, 2048, (bf16_t*)(ws + OFF_WPO), 1024, smf, (bi + 64) % nb, nb, wv);
            convT<0>(p.in[20], 2048, 2048, 2048, (bf16_t*)(ws + OFF_WOUT), 2048, smf, bi, nb, wv);
            {
                bf16_t* z = (bf16_t*)(ws + OFF_WUVT) + (size_t)2048 * 512;
                for (int i = bi * 512 + TIDX; i < 128 * 512 / 8; i += nb * 512) *(u32x4*)(z + (size_t)i * 8) = (u32x4){0u, 0u, 0u, 0u};
            }
}

DI void phase_token_local(const Params& p, unsigned char* ws, float* sm, const int wv) {
    const int lane = lane_id(), gw = blockIdx.x * 8 + wv, nw = gridDim.x * 8;
    const float* Z = (const float*)(ws + OFF_Z); const float* QLR = (const float*)(ws + OFF_QLR); const float* CKR = (const float*)(ws + OFF_CKR);
    bf16_t* QLAT = (bf16_t*)(ws + OFF_QLAT); bf16_t* CKVP = (bf16_t*)(ws + OFF_CKVP); bf16_t* POOLED = (bf16_t*)(ws + OFF_POOLED);
    bf16_t* KALL = (bf16_t*)(ws + OFF_KALL); bf16_t* CKVT = (bf16_t*)(ws + OFF_CKVT); const bf16_t* KRB = (const bf16_t*)(ws + OFF_KRB);
    const float* gq = p.in[11]; const float* gkv = p.in[12]; const float* spool = p.in[4];
    for (int r = gw; r < NTOK; r += nw) {
        const bool smp = r >= NPT; const int b = smp ? (r - NPT) >> 5 : r >> 11, t = smp ? (r - NPT) & 31 : r & 2047;
        const float* qp = QLR + (size_t)r * 512 + lane * 8; const f32x4 qa = *(const f32x4*)qp, qc = *(const f32x4*)(qp + 4);
        const float* cp = CKR + (size_t)r * 512 + lane * 8; f32x4 ca = *(const f32x4*)cp, cc = *(const f32x4*)(cp + 4);
        f32x4 self[4], pv[4];
#pragma unroll
        for (int g = 0; g < 4; ++g) self[g] = *(const f32x4*)(Z + (size_t)r * 1024 + 256 * g + 4 * lane);
#pragma unroll
        for (int g = 0; g < 4; ++g) {
            const int w = 2 << g, c = 256 * g + 4 * lane;
            f32x4 s = self[g];
            for (int j = 1; j < w; ++j) { const int tt = t - j;
                if (tt >= 0) s += *(const f32x4*)(Z + (size_t)(r - j) * 1024 + c);
                else if (smp) s += *(const f32x4*)(spool + ((size_t)b * 15 + 15 + tt) * 1024 + c); }
            const float cnt = smp ? (float)w : (float)(t + 1 < w ? t + 1 : w);
            pv[g] = s * (1.0f / cnt) - self[g];
        }
        float ssq = qa[0] * qa[0] + qa[1] * qa[1] + qa[2] * qa[2] + qa[3] * qa[3] + qc[0] * qc[0] + qc[1] * qc[1] + qc[2] * qc[2] + qc[3] * qc[3];
        float ssc = ca[0] * ca[0] + ca[1] * ca[1] + ca[2] * ca[2] + ca[3] * ca[3] + cc[0] * cc[0] + cc[1] * cc[1] + cc[2] * cc[2] + cc[3] * cc[3];
        ssq = wave_sum(ssq); ssc = wave_sum(ssc);
        const float rq = rsqrtf(ssq * (1.0f / 512.0f) + 1e-6f), rc = rsqrtf(ssc * (1.0f / 512.0f) + 1e-6f);
        const f32x4 gq0 = *(const f32x4*)(gq + lane * 8), gq1 = *(const f32x4*)(gq + lane * 8 + 4), gk0 = *(const f32x4*)(gkv + lane * 8), gk1 = *(const f32x4*)(gkv + lane * 8 + 4);
        u32x4 krw = (u32x4){0u, 0u, 0u, 0u}; if (smp && lane < 8) krw = *(const u32x4*)(KRB + (size_t)r * 64 + lane * 8);
        {   u32x4 w; w.x = cvt_pk_bf16(qa[0] * rq * gq0[0], qa[1] * rq * gq0[1]); w.y = cvt_pk_bf16(qa[2] * rq * gq0[2], qa[3] * rq * gq0[3]);
            w.z = cvt_pk_bf16(qc[0] * rq * gq1[0], qc[1] * rq * gq1[1]); w.w = cvt_pk_bf16(qc[2] * rq * gq1[2], qc[3] * rq * gq1[3]);
            *(u32x4*)(QLAT + (size_t)r * 512 + lane * 8) = w; }
        {   ca = ca * rc * gk0; cc = cc * rc * gk1;
            float* of = smp ? p.out + OUT_CKV_S + (size_t)(r - NPT) * 512 : p.out + OUT_CKV_P + (size_t)r * 512;
            *(f32x4*)(of + lane * 8) = ca; *(f32x4*)(of + lane * 8 + 4) = cc;
            u32x4 w; w.x = cvt_pk_bf16(ca[0], ca[1]); w.y = cvt_pk_bf16(ca[2], ca[3]); w.z = cvt_pk_bf16(cc[0], cc[1]); w.w = cvt_pk_bf16(cc[2], cc[3]);
            if (!smp) *(u32x4*)(CKVP + (size_t)r * 512 + lane * 8) = w;
            else {
                bf16_t* kr = KALL + ((size_t)b * 1056 + 1024 + t) * 640;
                *(u32x4*)(kr + lane * 8) = w;
                if (lane < 16) *(u32x4*)(kr + 512 + lane * 8) = krw;
                bf16_t* ct = CKVT + ((size_t)b * 512 + lane * 8) * 1152 + 1024 + t;
                ct[0] = (bf16_t)(w.x & 0xffff); ct[1152] = (bf16_t)(w.x >> 16); ct[2 * 1152] = (bf16_t)(w.y & 0xffff); ct[3 * 1152] = (bf16_t)(w.y >> 16);
                ct[4 * 1152] = (bf16_t)(w.z & 0xffff); ct[5 * 1152] = (bf16_t)(w.z >> 16); ct[6 * 1152] = (bf16_t)(w.w & 0xffff); ct[7 * 1152] = (bf16_t)(w.w >> 16);
            } }
#pragma unroll
        for (int g = 0; g < 4; ++g) { const int c = 256 * g + 4 * lane;
            u32x2 o; o.x = cvt_pk_bf16(pv[g][0], pv[g][1]); o.y = cvt_pk_bf16(pv[g][2], pv[g][3]);
            *(u32x2*)(POOLED + (size_t)r * 1024 + c) = o;
            if (!smp && t >= 2033) *(f32x4*)(p.out + OUT_POOL_P + ((size_t)b * 15 + (t - 2033)) * 1024 + c) = self[g];
            if (smp && t >= 17) *(f32x4*)(p.out + OUT_POOL_S + ((size_t)b * 15 + (t - 17)) * 1024 + c) = self[g]; }
    }
}

DI void convert_cache(const Params& p, unsigned char* ws, float* sm, const int bi, const int nb, const int wv) {
    const int lane = lane_id(), gw = bi * 8 + wv, nw = nb * 8;
    bf16_t* KALL = (bf16_t*)(ws + OFF_KALL); bf16_t* CKVT = (bf16_t*)(ws + OFF_CKVT);
    const float* cckv = p.in[2]; const float* ckr = p.in[3];
    for (int r0 = gw; r0 < 32 * 1024; r0 += 4 * nw) {
        f32x4 a[4], c[4], e[4], f[4];
#pragma unroll
        for (int k = 0; k < 4; ++k) { const int rr = r0 + k * nw;
            if (rr < 32 * 1024) { const float* sp = cckv + (size_t)rr * 512 + lane * 8; a[k] = *(const f32x4*)sp; c[k] = *(const f32x4*)(sp + 4);
                if (lane < 8) { const float* s2 = ckr + (size_t)rr * 64 + lane * 8; e[k] = *(const f32x4*)s2; f[k] = *(const f32x4*)(s2 + 4); } } }
#pragma unroll
        for (int k = 0; k < 4; ++k) { const int rr = r0 + k * nw;
            if (rr < 32 * 1024) { const int b = rr >> 10, key = rr & 1023;
                u32x4 w; w.x = cvt_pk_bf16(a[k][0], a[k][1]); w.y = cvt_pk_bf16(a[k][2], a[k][3]); w.z = cvt_pk_bf16(c[k][0], c[k][1]); w.w = cvt_pk_bf16(c[k][2], c[k][3]);
                bf16_t* kr = KALL + ((size_t)b * 1056 + key) * 640;
                *(u32x4*)(kr + lane * 8) = w;
                if (lane < 8) { u32x4 w2; w2.x = cvt_pk_bf16(e[k][0], e[k][1]); w2.y = cvt_pk_bf16(e[k][2], e[k][3]); w2.z = cvt_pk_bf16(f[k][0], f[k][1]); w2.w = cvt_pk_bf16(f[k][2], f[k][3]);
                    *(u32x4*)(kr + 512 + lane * 8) = w2; }
                else if (lane < 16) *(u32x4*)(kr + 512 + lane * 8) = (u32x4){0u, 0u, 0u, 0u}; } }
    }
    for (int b = 0; b < 32; ++b)
        convT<0>(cckv + (size_t)b * 1024 * 512, 512, 1024, 512, CKVT + (size_t)b * 512 * 1152, 1152, sm, (bi + b * 8) % nb, nb, wv);
    for (int i = bi * 512 + TIDX; i < 32 * 512 * 12; i += nb * 512) { const int row = i / 12, part = i - row * 12;
        *(u32x4*)(CKVT + (size_t)row * 1152 + 1056 + part * 8) = (u32x4){0u, 0u, 0u, 0u}; }
}

constexpr int ATT_KN = 0, ATT_KR = 16384, ATT_V = 24576, ATT_BUF = 40960;
#define MFMA32(a, b, c) __builtin_amdgcn_mfma_f32_32x32x16_bf16((a), (b), (c), 0, 0, 0)
DI void attn_item(unsigned char* ws, LAS unsigned char* lds, int b, int h, int qt, const int wv) {
    const int wid = wv, lane = lane_id(), tid = wid * 64 + lane, q = lane & 31, g = lane >> 5;
    const bf16_t* QN = (const bf16_t*)(ws + OFF_QN); const bf16_t* QR = (const bf16_t*)(ws + OFF_QR);
    const unsigned char* KN = ws + OFF_KN; const unsigned char* KRB = ws + OFF_KRB; const unsigned char* VT = ws + OFF_VT;
    const int qrow = b * 2048 + qt * 256 + wid * 32 + q;
    bf16x8 qf[12];
    { const bf16_t* qn = QN + (size_t)qrow * 2048 + h * 128 + 8 * g;
#pragma unroll
      for (int s = 0; s < 8; ++s) qf[s] = *(const bf16x8*)(qn + 16 * s);
      const bf16_t* qr = QR + (size_t)qrow * 1024 + h * 64 + 8 * g;
#pragma unroll
      for (int s = 0; s < 4; ++s) qf[8 + s] = *(const bf16x8*)(qr + 16 * s); }
    f32x16 o[4];
#pragma unroll
    for (int d = 0; d < 4; ++d)
#pragma unroll
        for (int i = 0; i < 16; ++i) o[d][i] = 0.f;
    float mrun = -1e30f, lrun = 0.f;
    const int ntiles = 4 * qt + 4, my_last = 4 * qt + (wid >> 1);
    const size_t tok0 = (size_t)b * 2048;
    const int knr = 8 * wid + (lane >> 4), knc = (lane & 15) ^ (knr & 15);
    const int knr1 = knr + 4, knc1 = (lane & 15) ^ (knr1 & 15);
    const int krr = 8 * wid + (lane >> 3), krc = (lane & 7) ^ ((krr >> 1) & 7);
    const int vr = 16 * wid + (lane >> 3), vc = (lane & 7) ^ ((vr >> 1) & 7);
    const int vr1 = vr + 8, vc1 = (lane & 7) ^ ((vr1 >> 1) & 7);
    const unsigned okn0 = (unsigned)(tok0 + knr) * 4096u + h * 256 + knc * 16, okn1 = (unsigned)(tok0 + knr1) * 4096u + h * 256 + knc1 * 16;
    const unsigned okr = (unsigned)(tok0 + krr) * 128u + krc * 16;
    const unsigned ov0 = ((unsigned)(h * 128 + vr) * 8192u + (unsigned)tok0) * 2u + vc * 16, ov1 = ((unsigned)(h * 128 + vr1) * 8192u + (unsigned)tok0) * 2u + vc1 * 16;
#define ATT_DMA(j, buf) do { LAS unsigned char* _b = lds + (buf) * ATT_BUF; const unsigned _j = (unsigned)(j); \
        __builtin_amdgcn_global_load_lds((const unsigned*)(KN + (size_t)(okn0 + _j * 262144u)), (LAS unsigned*)(_b + ATT_KN + wid * 2048), 16, 0, 0); \
        __builtin_amdgcn_global_load_lds((const unsigned*)(KN + (size_t)(okn1 + _j * 262144u)), (LAS unsigned*)(_b + ATT_KN + wid * 2048 + 1024), 16, 0, 0); \
        __builtin_amdgcn_global_load_lds((const unsigned*)(KRB + (size_t)(okr + _j * 8192u)), (LAS unsigned*)(_b + ATT_KR + wid * 1024), 16, 0, 0); \
        __builtin_amdgcn_global_load_lds((const unsigned*)(VT + (size_t)(ov0 + _j * 128u)), (LAS unsigned*)(_b + ATT_V + wid * 2048), 16, 0, 0); \
        __builtin_amdgcn_global_load_lds((const unsigned*)(VT + (size_t)(ov1 + _j * 128u)), (LAS unsigned*)(_b + ATT_V + wid * 2048 + 1024), 16, 0, 0); } while (0)
    ATT_DMA(0, 0);
    asm volatile("s_waitcnt vmcnt(0)" ::: "memory");
    __syncthreads();
    const int krow = (q & ~12) | ((q & 4) << 1) | ((q & 8) >> 1);
    const int kx = krow & 15, ksw = (krow >> 1) & 7, vsw = (q >> 1) & 7;
    const unsigned kn_b = ATT_KN + krow * 256 + ((g ^ kx) & 1) * 16, kn_t = (unsigned)(kx >> 1) << 5;
    const unsigned kr_b = ATT_KR + krow * 128 + ((g ^ ksw) & 1) * 16, kr_t = (unsigned)(ksw >> 1) << 5;
    const unsigned v_b = ATT_V + q * 128 + ((g ^ vsw) & 1) * 16, v_t = (unsigned)(vsw >> 1) << 5;
    const bool grpY = wid >= 4;
    bf16x8 pf[4];
#pragma unroll
    for (int s = 0; s < 4; ++s) pf[s] = (bf16x8){0, 0, 0, 0, 0, 0, 0, 0};
#define ATT_VF(d, s) (*(const LAS bf16x8*)(bb + v_b + (d) * 32 * 128 + (((unsigned)(s) << 5) ^ vtt)))
#define ATT_PV(bufidx) do { LAS unsigned char* bb = lds + (bufidx) * ATT_BUF; unsigned vtt = v_t; asm volatile("" : "+v"(vtt)); \
            bf16x8 va[4], vb[4]; \
            _Pragma("unroll") \
            for (int s = 0; s < 4; ++s) va[s] = ATT_VF(0, s); \
            _Pragma("unroll") \
            for (int s = 0; s < 4; ++s) vb[s] = ATT_VF(1, s); \
            __builtin_amdgcn_sched_barrier(0); \
            _Pragma("unroll") \
            for (int s = 0; s < 4; ++s) o[0] = MFMA32(va[s], pf[s], o[0]); \
            _Pragma("unroll") \
            for (int s = 0; s < 4; ++s) va[s] = ATT_VF(2, s); \
            __builtin_amdgcn_sched_barrier(0); \
            _Pragma("unroll") \
            for (int s = 0; s < 4; ++s) o[1] = MFMA32(vb[s], pf[s], o[1]); \
            _Pragma("unroll") \
            for (int s = 0; s < 4; ++s) vb[s] = ATT_VF(3, s); \
            __builtin_amdgcn_sched_barrier(0); \
            _Pragma("unroll") \
            for (int s = 0; s < 4; ++s) o[2] = MFMA32(va[s], pf[s], o[2]); \
            _Pragma("unroll") \
            for (int s = 0; s < 4; ++s) o[3] = MFMA32(vb[s], pf[s], o[3]); \
        } while (0)
    int bj = 0, bprev = 2;
    for (int j = 0; j < ntiles; ++j) {
        const int bnext = (bj == 2) ? 0 : bj + 1;
        if (j + 1 < ntiles) ATT_DMA(j + 1, bnext);
        if (grpY && j >= 1 && j - 1 <= my_last) ATT_PV(bprev);
        if (j <= my_last) {
            LAS unsigned char* bb = lds + bj * ATT_BUF;
            f32x16 sa[2];
#pragma unroll
            for (int mb = 0; mb < 2; ++mb)
#pragma unroll
                for (int i = 0; i < 16; ++i) sa[mb][i] = 0.f;
            unsigned knt = kn_t, krt = kr_t; asm volatile("" : "+v"(knt), "+v"(krt));
#define ATT_KF(mb, s) (*(const LAS bf16x8*)(bb + ((s) < 8 ? kn_b + (mb) * 32 * 256 + (((unsigned)(s) << 5) ^ knt) : kr_b + (mb) * 32 * 128 + (((unsigned)((s) - 8) << 5) ^ krt))))
            bf16x8 ka[3], kb[3];
#define ATT_LDG(dst, i) do { _Pragma("unroll") for (int s_ = 0; s_ < 3; ++s_) dst[s_] = ATT_KF((i) >> 2, 3 * ((i) & 3) + s_); } while (0)
#define ATT_MMG(src, i) do { _Pragma("unroll") for (int s_ = 0; s_ < 3; ++s_) sa[(i) >> 2] = MFMA32(src[s_], qf[3 * ((i) & 3) + s_], sa[(i) >> 2]); } while (0)
            ATT_LDG(ka, 0); ATT_LDG(kb, 1); __builtin_amdgcn_sched_barrier(0);
            ATT_MMG(ka, 0); ATT_LDG(ka, 2); __builtin_amdgcn_sched_barrier(0);
            ATT_MMG(kb, 1); ATT_LDG(kb, 3); __builtin_amdgcn_sched_barrier(0);
            ATT_MMG(ka, 2); ATT_LDG(ka, 4); __builtin_amdgcn_sched_barrier(0);
            ATT_MMG(kb, 3); ATT_LDG(kb, 5); __builtin_amdgcn_sched_barrier(0);
            ATT_MMG(ka, 4); ATT_LDG(ka, 6); __builtin_amdgcn_sched_barrier(0);
            ATT_MMG(kb, 5); ATT_LDG(kb, 7); __builtin_amdgcn_sched_barrier(0);
            ATT_MMG(ka, 6); ATT_MMG(kb, 7); __builtin_amdgcn_sched_barrier(0);
#undef ATT_LDG
#undef ATT_MMG
#undef ATT_KF
            float mx = sa[0][0];
#pragma unroll
            for (int i = 0; i < 16; ++i) { mx = fmaxf(mx, sa[0][i]); mx = fmaxf(mx, sa[1][i]); }
            mx = fmaxf(mx, __shfl_xor(mx, 32));
            const float mnew = fmaxf(mrun, mx), alpha = __builtin_amdgcn_exp2f(mrun - mnew);
            float ps = 0.f;
#pragma unroll
            for (int mb = 0; mb < 2; ++mb)
#pragma unroll
                for (int i = 0; i < 16; ++i) { const float e = __builtin_amdgcn_exp2f(sa[mb][i] - mnew); sa[mb][i] = e; ps += e; }
            lrun = lrun * alpha + ps; mrun = mnew;
#pragma unroll
            for (int d = 0; d < 4; ++d)
#pragma unroll
                for (int i = 0; i < 16; ++i) o[d][i] *= alpha;
#pragma unroll
            for (int s = 0; s < 4; ++s) { const int mb = s >> 1, o8 = (s & 1) * 8; u32x4 w;
                w.x = cvt_pk_bf16(sa[mb][o8 + 0], sa[mb][o8 + 1]); w.y = cvt_pk_bf16(sa[mb][o8 + 2], sa[mb][o8 + 3]); w.z = cvt_pk_bf16(sa[mb][o8 + 4], sa[mb][o8 + 5]); w.w = cvt_pk_bf16(sa[mb][o8 + 6], sa[mb][o8 + 7]);
                pf[s] = __builtin_bit_cast(bf16x8, w); }
        }
        if (!grpY && j <= my_last) ATT_PV(bj);
        asm volatile("s_waitcnt vmcnt(0)" ::: "memory");
        __syncthreads();
        bprev = bj; bj = bnext;
    }
    if (grpY && ntiles - 1 <= my_last) ATT_PV(bprev);
#undef ATT_PV
#undef ATT_VF
    const float lt = lrun + __shfl_xor(lrun, 32), il = 1.0f / lt;
    bf16_t* op = (bf16_t*)(ws + OFF_O) + (size_t)qrow * 2048 + h * 128 + 4 * g;
#pragma unroll
    for (int d = 0; d < 4; ++d)
#pragma unroll
        for (int i = 0; i < 4; ++i) { u32x2 w; w.x = cvt_pk_bf16(o[d][4 * i] * il, o[d][4 * i + 1] * il); w.y = cvt_pk_bf16(o[d][4 * i + 2] * il, o[d][4 * i + 3] * il);
            *(u32x2*)(op + 32 * d + 8 * i) = w; }
#undef ATT_DMA
}

DI void phase_softmax(unsigned char* ws, const int wv) {
    const _Float16* S = (const _Float16*)(ws + OFF_S); bf16_t* P = (bf16_t*)(ws + OFF_P);
    const int lane = lane_id(), gw = blockIdx.x * 8 + wv, nw = gridDim.x * 8;
    for (int r = gw; r < 16384; r += nw) {
        const _Float16* sp = S + (size_t)r * 1056;
        f32x4 v[5]; float mx = -1e30f;
#pragma unroll
        for (int k = 0; k < 5; ++k) { const int ci = lane + 64 * k; if (ci < 264) { v[k] = __builtin_convertvector(*(const f16x4*)(sp + ci * 4), f32x4); mx = fmaxf(mx, fmaxf(fmaxf(v[k][0], v[k][1]), fmaxf(v[k][2], v[k][3]))); } else v[k] = (f32x4){-1e30f, -1e30f, -1e30f, -1e30f}; }
        mx = wave_max(mx);
        float sum = 0.f;
#pragma unroll
        for (int k = 0; k < 5; ++k) { const int ci = lane + 64 * k;
#pragma unroll
            for (int e = 0; e < 4; ++e) { const float x = (ci < 264) ? __builtin_amdgcn_exp2f(v[k][e] - mx) : 0.f; v[k][e] = x; sum += x; } }
        sum = wave_sum(sum); const float is = 1.0f / sum;
#pragma unroll
        for (int k = 0; k < 5; ++k) { const int ci = lane + 64 * k; if (ci < 288) { u32x2 w; w.x = cvt_pk_bf16(v[k][0] * is, v[k][1] * is); w.y = cvt_pk_bf16(v[k][2] * is, v[k][3] * is);
            *(u32x2*)(P + (size_t)r * 1152 + ci * 4) = w; } }
    }
}


#define XB_TMO      128
#define XB_XCNT(j)  (256  + 64 * (j))
#define XB_XSUB(j)  (1280 + 64 * (j))
#define XB_XGEN(j)  (2304 + 64 * (j))
#define XB_TOP      3328
#define XB_TOPGEN   3392
#define XCD_BAR_WORDS 3456
#define XB_SPIN_CAP (1u << 22)
DI unsigned xb_ld(unsigned* p)              { return __hip_atomic_load(p, __ATOMIC_RELAXED, __HIP_MEMORY_SCOPE_AGENT); }
DI unsigned xb_add(unsigned* p, unsigned v) { return __hip_atomic_fetch_add(p, v, __ATOMIC_RELAXED, __HIP_MEMORY_SCOPE_AGENT); }
DI unsigned xb_xcc_id() { return (unsigned)__builtin_amdgcn_s_getreg((3 << 11) | 20) & 0xFu; }
#define XB_SPIN(cond, bar) do { unsigned _sp = 0; while (cond) { __builtin_amdgcn_s_sleep(1); \
    if ((++_sp & 255u) == 0u) { if (xb_ld(&(bar)[XB_TMO])) break; if (_sp > XB_SPIN_CAP) { atomicAdd(&(bar)[XB_TMO], 1u); break; } } } } while (0)
struct XcdBarrier { unsigned* bar; unsigned x; volatile LAS unsigned* st; };
DI XcdBarrier xcd_barrier_post(unsigned* bar, volatile LAS unsigned* st, bool leader) {
    XcdBarrier b; b.bar = bar; b.x = xb_xcc_id(); b.st = st;
    if (leader) (void)xb_add(&bar[XB_XCNT(b.x)], 1u);
    return b;
}
DI void xcd_barrier_complete(unsigned* bar, unsigned x, unsigned& nloc, unsigned& nx) {
    const unsigned G = gridDim.x * gridDim.y * gridDim.z;
    unsigned sum, cnt, mine, sp = 0u;
    for (;;) {
        sum = 0u; cnt = 0u; mine = 0u;
#pragma unroll
        for (unsigned j = 0; j < 16; ++j) { const unsigned c = xb_ld(&bar[XB_XCNT(j)]); sum += c; cnt += (c > 0u) ? 1u : 0u; mine = (j == x) ? c : mine; }
        if (sum == G) break;
        __builtin_amdgcn_s_sleep(1);
        if ((++sp & 255u) == 0u) { if (xb_ld(&bar[XB_TMO])) break; if (sp > XB_SPIN_CAP) { atomicAdd(&bar[XB_TMO], 1u); break; } }
    }
    nloc = mine > 0u ? mine : 1u; nx = cnt > 0u ? cnt : 1u;
}
DI void xcd_barrier(const XcdBarrier& b, bool leader) {
    asm volatile("s_waitcnt vmcnt(0)" ::: "memory");
    __syncthreads();
    if (leader) {
        unsigned* bar = b.bar;
        __builtin_amdgcn_s_waitcnt(0);
        unsigned nloc = b.st[0], nx = b.st[1];
        if (nloc == 0u) { xcd_barrier_complete(bar, b.x, nloc, nx); b.st[0] = nloc; b.st[1] = nx; }
        const unsigned old = xb_add(&bar[XB_XSUB(b.x)], 1u);
        const unsigned gen = old / nloc;
        if (old + 1u == (gen + 1u) * nloc) {
            __builtin_amdgcn_fence(__ATOMIC_RELEASE, "agent");
            asm volatile("s_waitcnt vmcnt(0)" ::: "memory");
            const unsigned og = xb_add(&bar[XB_TOP], 1u);
            const unsigned tg = og / nx;
            if (og + 1u == (tg + 1u) * nx) xb_add(&bar[XB_TOPGEN], 1u);
            else XB_SPIN(xb_ld(&bar[XB_TOPGEN]) == tg, bar);
            __builtin_amdgcn_fence(__ATOMIC_ACQUIRE, "agent");
            xb_add(&bar[XB_XGEN(b.x)], 1u);
            asm volatile("s_waitcnt vmcnt(0)" ::: "memory");
        } else {
            XB_SPIN(xb_ld(&bar[XB_XGEN(b.x)]) == gen, bar);
            __builtin_amdgcn_fence(__ATOMIC_ACQUIRE, "agent");
            asm volatile("s_waitcnt vmcnt(0)" ::: "memory");
        }
    }
    __syncthreads();
}

#ifndef REPEAT_MASK
#define REPEAT_MASK 0
#endif
#define PH_REP(n) ((((REPEAT_MASK) >> (n)) & 1) ? 2 : 1)
#define PHASE_BEGIN(n) if (PH_ON((n) == 15 ? 1 : (n) == 16 ? 2 : (n)) && p.ph_lo <= (n) && (n) < p.ph_hi) { for (int rep_ = 0; rep_ < PH_REP(n); ++rep_) { unsigned long long wsi_ = (unsigned long long)p.ws, hi_ = (unsigned long long)p.out; asm volatile("" : "+s"(wsi_), "+s"(hi_)); unsigned char* ws = (unsigned char*)(GAS unsigned char*)wsi_; float* H = (float*)(GAS float*)hi_;
#define PHASE_END(n) } } if (p.ph_lo <= (n) && (n) + 1 < p.ph_hi) { xcd_barrier(xbar, xlead); }
__global__ void __launch_bounds__(512, 2) fwd_kernel(Params p) {
    extern __shared__ __attribute__((aligned(16))) unsigned char shm[];
    LAS unsigned char* lds = (LAS unsigned char*)shm;
    float* smf = (float*)shm;
    const int wv = __builtin_amdgcn_readfirstlane((int)(threadIdx.x >> 6));
    const bool xlead = (wv == 0) && (lane_id() == 0);
    volatile LAS unsigned* xst = (volatile LAS unsigned*)(lds + pg8::STAGE_BYTES);
    XcdBarrier xbar; xbar.bar = nullptr; xbar.x = 0; xbar.st = xst;
    if (p.ph_hi - p.ph_lo > 1) {
        if (xlead) { xst[0] = 0u; xst[1] = 0u; }
        __syncthreads();
        xbar = xcd_barrier_post((unsigned*)(p.ws + WS_BAR), xst, xlead);
    }
    if (p.ph_lo > p.ph_hi) cg::this_grid().sync();
    using namespace pg8;
    PHASE_BEGIN(0) {
            convert_ffn_weights(p, ws, 0, smf, blockIdx.x, gridDim.x, wv, 1);
            rmsnorm_rows_bf16(p.in[0], p.in[1], p.in[5], (bf16_t*)(ws + OFF_XN), nullptr, nullptr, wv);
    } PHASE_END(0)
#define FFN_UP_BODY(spl) {     \
            Gemm g{}; g.A = (const char*)(ws + OFF_XN); g.B = (const char*)(ws + OFF_WGU); g.lda = 2048; g.ldb = 2048; g.K = 2048; g.nM = 36; g.nN = 44; g.nB = 1; g.split = spl; \
            g.a_ts = 256ll * 2048 * 2; g.b_ts = 256ll * 2048 * 2; \
            EpiSwiglu E{(bf16_t*)(ws + OFF_G), (float*)(ws + OFF_SLABG)}; \
            gemm_phase(lds, g, E, wv); }
    PHASE_BEGIN(1) FFN_UP_BODY(0)
        { const int extra = (36 * 44) % (int)gridDim.x, nconv = (int)gridDim.x - extra;
          if (extra == 0) { convert_ffn_weights(p, ws, 0, smf, blockIdx.x, gridDim.x, wv, 2); convert_other_weights(p, ws, smf, blockIdx.x, gridDim.x, wv); }
          else if ((int)blockIdx.x >= extra) { convert_ffn_weights(p, ws, 0, smf, blockIdx.x - extra, nconv, wv, 2); convert_other_weights(p, ws, smf, blockIdx.x - extra, nconv, wv); } }
    PHASE_END(1)
#define FFN_DOWN_BODY(ph) {     \
            Gemm g{}; g.A = (const char*)(ws + OFF_G); g.B = (const char*)(ws + OFF_WD); g.lda = DFF; g.ldb = DFF; g.K = DFF; g.nM = 36; g.nN = 8; g.nB = 1; g.split = 1; \
            g.a_ts = 256ll * DFF * 2; g.b_ts = 256ll * DFF * 2; \
            EpiResid E{H, ph == 2 ? p.in[0] : H, ph == 2 ? p.in[1] : H + (size_t)NPT * DM, 0.5f, (float*)(ws + OFF_SLAB), ph == 2 ? nullptr : (const bf16_t*)(ws + OFF_HB), ph == 2 ? (bf16_t*)(ws + OFF_HB) : nullptr}; \
            gemm_phase(lds, g, E, wv); }
    PHASE_BEGIN(2) FFN_DOWN_BODY(2) PHASE_END(2)
    PHASE_BEGIN(3) rmsnorm_rows_bf16(H, p.in[1], p.in[9], (bf16_t*)(ws + OFF_XN), (const float*)(ws + OFF_SLAB), H + (size_t)NPT * DM, wv, (const bf16_t*)(ws + OFF_HB)); PHASE_END(3)
    PHASE_BEGIN(4) {
            Gemm g{}; g.A = (const char*)(ws + OFF_XN); g.B = (const char*)(ws + OFF_WIN); g.lda = 2048; g.ldb = 2048; g.K = 2048; g.nM = 36; g.nN = 25; g.nB = 1;
            g.a_ts = 256ll * 2048 * 2; g.b_ts = 256ll * 2048 * 2;
            EpiWin E{(float*)(ws + OFF_Z), (float*)(ws + OFF_QLR), (float*)(ws + OFF_CKR), (bf16_t*)(ws + OFF_GATES), (bf16_t*)(ws + OFF_KRB), p.out + OUT_KR_P, p.out + OUT_KR_S};
            gemm_phase(lds, g, E, wv);
            { const int extra = (36 * 25) % (int)gridDim.x, nconv = (int)gridDim.x - extra;
              if (extra == 0) convert_cache(p, ws, smf, blockIdx.x, gridDim.x, wv); else if ((int)blockIdx.x >= extra) convert_cache(p, ws, smf, blockIdx.x - extra, nconv, wv); }
    } PHASE_END(4)
    PHASE_BEGIN(5) phase_token_local(p, ws, smf, wv);
        {
            const float* s = p.in[14]; bf16_t* d = (bf16_t*)(ws + OFF_WUKP);
            for (int i = blockIdx.x * 512 + TIDX; i < 512 * 2048 / 8; i += gridDim.x * 512) { const f32x4 a = *(const f32x4*)(s + (size_t)i * 8), c = *(const f32x4*)(s + (size_t)i * 8 + 4);
                u32x4 w; w.x = cvt_pk_bf16(a[0], a[1]); w.y = cvt_pk_bf16(a[2], a[3]); w.z = cvt_pk_bf16(c[0], c[1]); w.w = cvt_pk_bf16(c[2], c[3]); *(u32x4*)(d + (size_t)i * 8) = w; }
        }
    PHASE_END(5)
    PHASE_BEGIN(6) {
            {
                Gemm g{}; g.A = (const char*)(ws + OFF_QLAT); g.B = (const char*)(ws + OFF_WUQ); g.lda = 512; g.ldb = 512; g.K = 512; g.nM = 36; g.nN = 12; g.nB = 1;
                g.a_ts = 256ll * 512 * 2; g.b_ts = 256ll * 512 * 2;
                EpiQ E{(bf16_t*)(ws + OFF_QN), (bf16_t*)(ws + OFF_QR), (bf16_t*)(ws + OFF_QABS)};
                gemm_phase(lds, g, E, wv);
            }
            {
                Gemm g{}; g.A = (const char*)(ws + OFF_CKVP); g.B = (const char*)(ws + OFF_WUKT); g.lda = 512; g.ldb = 512; g.K = 512; g.nM = 32; g.nN = 8; g.nB = 1;
                g.a_ts = 256ll * 512 * 2; g.b_ts = 256ll * 512 * 2; g.rot = 176;
                EpiBf16 E{(bf16_t*)(ws + OFF_KN), 2048, 0, 1.0f, 0};
                gemm_phase(lds, g, E, wv);
            }
            {
                Gemm g{}; g.A = (const char*)(ws + OFF_WUVT); g.B = (const char*)(ws + OFF_CKVP); g.lda = 512; g.ldb = 512; g.K = 512; g.nM = 8; g.nN = 32; g.nB = 1;
                g.a_ts = 256ll * 512 * 2; g.b_ts = 256ll * 512 * 2; g.rot = 176;
                EpiBf16 E{(bf16_t*)(ws + OFF_VT), 8192, 0, 1.0f, 0};
                gemm_phase(lds, g, E, wv);
            }
            {
                Gemm g{}; g.A = (const char*)(ws + OFF_POOLED); g.B = (const char*)(ws + OFF_WPOOL); g.lda = 1024; g.ldb = 256; g.K = 256; g.nM = 36; g.nN = 1; g.nB = 4;
                g.a_ts = 256ll * 1024 * 2; g.b_ts = 0; g.a_bs = 512; g.b_bs = 65536ll * 2; g.rot = 176;
                EpiPoolMix E{(bf16_t*)(ws + OFF_MIXED), p.in[18]};
                gemm_phase(lds, g, E, wv);
            }
    } PHASE_END(6)
    PHASE_BEGIN(7) {
            {
                Gemm g{}; g.A = (const char*)(ws + OFF_QN) + (size_t)NPT * 2048 * 2; g.B = (const char*)(ws + OFF_WUKP); g.lda = 2048; g.ldb = 2048; g.K = 128; g.nM = 4; g.nN = 2; g.nB = 16;
                g.a_ts = 256ll * 2048 * 2; g.b_ts = 256ll * 2048 * 2; g.a_bs = 256; g.b_bs = 256; g.rot = 32;
                EpiBf16 E{(bf16_t*)(ws + OFF_QABS), 16 * 640, 640, 1.0f, 0};
                gemm_phase(lds, g, E, wv);
            }
            {
                const int c = blockIdx.x;
                for (int pr = c; pr < 256; pr += gridDim.x) {
                    const int bh = (pr & 7) * 8 + ((pr >> 3) >> 2), i = (pr >> 3) & 3;
                    attn_item(ws, lds, bh >> 4, bh & 15, 7 - i, wv);
                    attn_item(ws, lds, bh >> 4, bh & 15, i, wv);
                }
            }
    } PHASE_END(7)
    PHASE_BEGIN(8) {
            Gemm g{}; g.A = (const char*)(ws + OFF_QABS); g.B = (const char*)(ws + OFF_KALL); g.lda = 640; g.ldb = 640; g.K = 640; g.nM = 2; g.nN = 5; g.nB = 32;
            g.a_ts = 256ll * 640 * 2; g.b_ts = 256ll * 640 * 2; g.a_bs = 512ll * 640 * 2; g.b_bs = 1056ll * 640 * 2;
            EpiScore E{(_Float16*)(ws + OFF_S)};
            gemm_phase(lds, g, E, wv);
    } PHASE_END(8)
    PHASE_BEGIN(9) phase_softmax(ws, wv); PHASE_END(9)
    PHASE_BEGIN(10) {
            Gemm g{}; g.A = (const char*)(ws + OFF_P); g.B = (const char*)(ws + OFF_CKVT); g.lda = 1152; g.ldb = 1152; g.K = 1152; g.nM = 2; g.nN = 2; g.nB = 32;
            g.a_ts = 256ll * 1152 * 2; g.b_ts = 256ll * 1152 * 2; g.a_bs = 512ll * 1152 * 2; g.b_bs = 512ll * 1152 * 2;
            EpiBf16 E{(bf16_t*)(ws + OFF_OLAT), 512, 512ll * 512, 1.0f, 0};
            gemm_phase(lds, g, E, wv);
            {
                Gemm g2{}; g2.A = (const char*)(ws + OFF_MIXED); g2.B = (const char*)(ws + OFF_WPO); g2.lda = 1024; g2.ldb = 1024; g2.K = 1024; g2.nM = 36; g2.nN = 8; g2.nB = 1;
                g2.a_ts = 256ll * 1024 * 2; g2.b_ts = 256ll * 1024 * 2; g2.u0 = 0; g2.u1 = 128; g2.boff = 128; g2.nblk = (int)gridDim.x - 128;
                EpiGate E2{(bf16_t*)(ws + OFF_GA), (const bf16_t*)(ws + OFF_GATES), nullptr, 0, 0};
                gemm_phase(lds, g2, E2, wv);
            }
    } PHASE_END(10)
    PHASE_BEGIN(11) {
            {
            Gemm g{}; g.A = (const char*)(ws + OFF_OLAT); g.B = (const char*)(ws + OFF_WUVT); g.lda = 8192; g.ldb = 512; g.K = 512; g.nM = 4; g.nN = 1; g.nB = 16;
            g.a_ts = 256ll * 8192 * 2; g.b_ts = 0; g.a_bs = 512 * 2; g.b_bs = 128ll * 512 * 2;
            EpiBf16 E{(bf16_t*)(ws + OFF_O) + (size_t)NPT * 2048, 2048, 128, 1.0f, 1};
            gemm_phase(lds, g, E, wv);
            }
            {
                Gemm g{}; g.A = (const char*)(ws + OFF_MIXED); g.B = (const char*)(ws + OFF_WPO); g.lda = 1024; g.ldb = 1024; g.K = 1024; g.nM = 36; g.nN = 8; g.nB = 1;
                g.a_ts = 256ll * 1024 * 2; g.b_ts = 256ll * 1024 * 2; g.u0 = 128; g.u1 = 288; g.boff = 64; g.nblk = (int)gridDim.x - 64;
                EpiGate E{(bf16_t*)(ws + OFF_GA), (const bf16_t*)(ws + OFF_GATES), nullptr, 0, 0};
                gemm_phase(lds, g, E, wv);
            }
    } PHASE_END(11)
    PHASE_BEGIN(12) {
            Gemm g{}; g.A = (const char*)(ws + OFF_O); g.B = (const char*)(ws + OFF_WOA); g.lda = 2048; g.ldb = 2048; g.K = 2048; g.nM = 36; g.nN = 8; g.nB = 1;
            g.a_ts = 256ll * 2048 * 2; g.b_ts = 256ll * 2048 * 2;
            EpiGate E{(bf16_t*)(ws + OFF_MERGED), (const bf16_t*)(ws + OFF_GATES), (const bf16_t*)(ws + OFF_GA), 2048, 1};
            gemm_phase(lds, g, E, wv);
            { const int extra = (36 * 8) % (int)gridDim.x, nconv = (int)gridDim.x - extra;
              if (extra == 0) convert_ffn_weights(p, ws, 1, smf, blockIdx.x, gridDim.x, wv); else if ((int)blockIdx.x >= extra) convert_ffn_weights(p, ws, 1, smf, blockIdx.x - extra, nconv, wv); }
    } PHASE_END(12)
    PHASE_BEGIN(13) {
            Gemm g{}; g.A = (const char*)(ws + OFF_MERGED); g.B = (const char*)(ws + OFF_WOUT); g.lda = 2048; g.ldb = 2048; g.K = 2048; g.nM = 36; g.nN = 8; g.nB = 1; g.split = 1;
            g.a_ts = 256ll * 2048 * 2; g.b_ts = 256ll * 2048 * 2;
            EpiResid E{H, H, H + (size_t)NPT * DM, 1.0f, (float*)(ws + OFF_SLAB), (const bf16_t*)(ws + OFF_HB), (bf16_t*)(ws + OFF_HB)};
            gemm_phase(lds, g, E, wv);
    } PHASE_END(13)
    PHASE_BEGIN(14) {
            rmsnorm_rows_bf16(H, H + (size_t)NPT * DM, p.in[21], (bf16_t*)(ws + OFF_XN), (const float*)(ws + OFF_SLAB), H + (size_t)NPT * DM, wv, (const bf16_t*)(ws + OFF_HB));
    } PHASE_END(14)
    PHASE_BEGIN(15) FFN_UP_BODY((p.ph_hi - p.ph_lo > 1) ? 2 : 0) PHASE_END(15)
    if (PH_ON(1) && p.ph_lo <= 15 && 16 < p.ph_hi) {
        unsigned long long wsi_ = (unsigned long long)p.ws; asm volatile("" : "+s"(wsi_)); unsigned char* ws = (unsigned char*)(GAS unsigned char*)wsi_;
        const int G_ = gridDim.x, nwg = 36 * 44, full = (nwg / G_) * G_, left = nwg - full, tid = TIDX;
        const int lane = tid & 63, wid = tid >> 6, wr = wid >> 2, wc = wid & 3, fr = lane & 15, fq = lane >> 4;
        const float* slab = (const float*)(ws + OFF_SLABG); bf16_t* Gout = (bf16_t*)(ws + OFF_G);
        for (int it = blockIdx.x; it < left * 16; it += G_) {
            const int lu = it >> 4, ai = (it >> 3) & 1, m = (it >> 1) & 3, n = it & 1; int pm, pn; pg8::map_unit(full + lu, 36, 44, nwg, pm, pn);
            f32x4 gs = (f32x4){0.f, 0.f, 0.f, 0.f}, us = gs;
#pragma unroll
            for (int kp = 0; kp < 4; ++kp) { const bf16_t* sp = (const bf16_t*)slab + ((size_t)(lu * 4 + kp) * 32 * 512 + tid) * 4;
                const u32x2 wg = *(const u32x2*)(sp + (size_t)(((ai * 2 + 0) * 4 + m) * 2 + n) * 2048), wu = *(const u32x2*)(sp + (size_t)(((ai * 2 + 1) * 4 + m) * 2 + n) * 2048);
                gs += (f32x4){bflo(wg.x), bfhi(wg.x), bflo(wg.y), bfhi(wg.y)}; us += (f32x4){bflo(wu.x), bfhi(wu.x), bflo(wu.y), bfhi(wu.y)}; }
            u32x2 w; w.x = cvt_pk_bf16(silu_f(gs[0]) * us[0], silu_f(gs[1]) * us[1]); w.y = cvt_pk_bf16(silu_f(gs[2]) * us[2], silu_f(gs[3]) * us[3]);
            *(u32x2*)(Gout + (size_t)(pm * 256 + ai * 128 + wr * 64 + m * 16 + fr) * DFF + pn * 128 + wc * 32 + 8 * fq + 4 * n) = w;
        }
        xcd_barrier(xbar, xlead);
    }
    PHASE_BEGIN(16) FFN_DOWN_BODY(16) PHASE_END(16)
    PHASE_BEGIN(17) {
            const int lane = lane_id(), gw = blockIdx.x * 8 + wv, nw = gridDim.x * 8; const float* gain = p.in[25];
            for (int r = gw; r < NTOK; r += nw) {
                float* sp = H + (size_t)r * DM; f32x4 v[8]; float ss = 0.f;
#pragma unroll
                for (int i = 0; i < 8; ++i) v[i] = *(const f32x4*)(sp + i * 256 + lane * 4);
                if (r >= NPT) {
#pragma unroll
                    for (int sidx = 0; sidx < 8; ++sidx) { const bf16_t* sl = (const bf16_t*)(ws + OFF_SLAB) + ((size_t)sidx * NST + (r - NPT)) * DM;
#pragma unroll
                        for (int i = 0; i < 8; ++i) { const u32x2 w = *(const u32x2*)(sl + i * 256 + lane * 4); v[i] += (f32x4){bflo(w.x), bfhi(w.x), bflo(w.y), bfhi(w.y)}; } }
                }
#pragma unroll
                for (int i = 0; i < 8; ++i) ss += v[i][0] * v[i][0] + v[i][1] * v[i][1] + v[i][2] * v[i][2] + v[i][3] * v[i][3];
                ss = wave_sum(ss); const float rstd = rsqrtf(ss * (1.0f / 2048.0f) + 1e-6f);
#pragma unroll
                for (int i = 0; i < 8; ++i) { const f32x4 g = *(const f32x4*)(gain + i * 256 + lane * 4); *(f32x4*)(sp + i * 256 + lane * 4) = v[i] * rstd * g; }
            }
    } PHASE_END(17)
}


extern "C" void kernel_launch(void* const* d_in, const int* in_sizes, int n_in, void* d_out, int out_size, void* d_ws, size_t ws_size, hipStream_t stream) {
    constexpr int LDS_BYTES = pg8::STAGE_BYTES + 16;
    static int grid = 0;
    if (grid == 0) {
        if (n_in != 26 || ws_size < WS_END || out_size != 24735744) { fprintf(stderr, "kernel_launch: unexpected problem (n_in %d, ws %zu need %zu, out %d)\n", n_in, ws_size, (size_t)WS_END, out_size); grid = -1; return; }
        int dev = 0, cus = 0, per_cu = 0;
        hipGetDevice(&dev); hipDeviceGetAttribute(&cus, hipDeviceAttributeMultiprocessorCount, dev);
        if (hipFuncSetAttribute((const void*)fwd_kernel, hipFuncAttributeMaxDynamicSharedMemorySize, LDS_BYTES) != hipSuccess) { fprintf(stderr, "kernel_launch: hipFuncSetAttribute failed\n"); grid = -1; return; }
        if (hipOccupancyMaxActiveBlocksPerMultiprocessor(&per_cu, (const void*)fwd_kernel, 512, LDS_BYTES) != hipSuccess || per_cu < 1) { fprintf(stderr, "kernel_launch: occupancy query failed (%d)\n", per_cu); (void)hipGetLastError(); per_cu = 1; }
        grid = cus * 1;
        (void)per_cu;
    }
    if (grid < 0) return;
    Params p{};
    for (int i = 0; i < 26; ++i) p.in[i] = (const float*)d_in[i];
    p.out = (float*)d_out; p.ws = (unsigned char*)d_ws;
#if SINGLE_LAUNCH
    p.ph_lo = 0; p.ph_hi = NPHASE;
    if (hipMemsetAsync((unsigned char*)d_ws + WS_BAR, 0, 16384, stream) != hipSuccess) { fprintf(stderr, "kernel_launch: memset of the barrier words failed\n"); return; }
    void* args[] = {&p};
    hipError_t e = hipLaunchCooperativeKernel((const void*)fwd_kernel, dim3(grid), dim3(512), args, LDS_BYTES, stream);
    if (e != hipSuccess) fprintf(stderr, "cooperative launch failed: %s (grid %d)\n", hipGetErrorString(e), grid);
#else
    for (int ph = 0; ph < NPHASE; ++ph) {
        p.ph_lo = ph; p.ph_hi = ph + 1;
        hipLaunchKernelGGL(fwd_kernel, dim3(grid), dim3(512), LDS_BYTES, stream, p);
    }
#endif
}
```

```cpp
#include <hip/hip_runtime.h>
#include <hip/hip_cooperative_groups.h>
#include <cstdio>
namespace cg = cooperative_groups;

#ifndef PHASE_MASK
#define PHASE_MASK 0x3ffff
#endif
#define PH_ON(n) (((PHASE_MASK) >> (n)) & 1)
#ifndef SINGLE_LAUNCH
#define SINGLE_LAUNCH 1
#endif

#define LAS __attribute__((address_space(3)))
#define GAS __attribute__((address_space(1)))
#define DI __device__ __forceinline__
typedef unsigned short bf16_t;
typedef short bf16x8 __attribute__((ext_vector_type(8)));
typedef float f32x4 __attribute__((ext_vector_type(4)));
typedef float f32x16 __attribute__((ext_vector_type(16)));
typedef unsigned u32x4 __attribute__((ext_vector_type(4)));
typedef unsigned u32x2 __attribute__((ext_vector_type(2)));
typedef _Float16 f16x4 __attribute__((ext_vector_type(4)));

constexpr int NTOK = 9216, NPT = 8192, NST = 1024, DM = 2048, DFF = 5632;
constexpr int NPHASE = 18;
constexpr float QSCALE = 0.07216878364870322f * 1.4426950408889634f;

constexpr size_t SZ_WGU = (size_t)11264 * 2048 * 2, SZ_WD = (size_t)2048 * 5632 * 2;
constexpr size_t OFF_WFF = 0;
constexpr size_t OFF_WGU = OFF_WFF, OFF_WD = OFF_WFF + SZ_WGU;
constexpr size_t SZ_WFF = SZ_WGU + SZ_WD;
constexpr size_t OFF_WIN = OFF_WFF + SZ_WFF;
constexpr size_t OFF_WUQ = OFF_WIN + (size_t)6400 * 2048 * 2;
constexpr size_t OFF_WUKT = OFF_WUQ + (size_t)3072 * 512 * 2;
constexpr size_t OFF_WUVT = OFF_WUKT + (size_t)2048 * 512 * 2;
constexpr size_t OFF_WOA = OFF_WUVT + (size_t)2176 * 512 * 2;
constexpr size_t OFF_WPOOL = OFF_WOA + (size_t)2048 * 2048 * 2;
constexpr size_t OFF_WPO = OFF_WPOOL + (size_t)4 * 256 * 256 * 2;
constexpr size_t OFF_WOUT = OFF_WPO + (size_t)2048 * 1024 * 2;
constexpr size_t OFF_XN = OFF_WOUT + (size_t)2048 * 2048 * 2;
constexpr size_t SZ_XN = (size_t)NTOK * 2048 * 2;
constexpr size_t OFF_G = OFF_XN + SZ_XN;
constexpr size_t SZ_G = (size_t)NTOK * DFF * 2;
constexpr size_t OFF_GATES = OFF_G + SZ_G;
constexpr size_t OFF_QN = OFF_GATES + (size_t)NTOK * 4096 * 2;
constexpr size_t OFF_O = OFF_QN + (size_t)NTOK * 2048 * 2;
constexpr size_t OFF_KALL = OFF_O + (size_t)NTOK * 2048 * 2;
constexpr size_t OFF_CKVT = OFF_KALL + (size_t)(32 * 1056 + 224) * 640 * 2;
constexpr size_t OFF_KRB = OFF_CKVT + (size_t)32 * 512 * 1152 * 2;
constexpr size_t OFF_HB = OFF_KRB + (size_t)NTOK * 64 * 2;
constexpr size_t WS_BAR = OFF_HB + (size_t)NTOK * 2048 * 2;
constexpr size_t WS_END = WS_BAR + 16384;
constexpr size_t OFF_Z = OFF_G;
constexpr size_t OFF_QLR = OFF_Z + (size_t)NTOK * 1024 * 4;
constexpr size_t OFF_CKR = OFF_QLR + (size_t)NTOK * 512 * 4;
constexpr size_t OFF_KN = OFF_G;
constexpr size_t OFF_VT = OFF_KN + (size_t)NPT * 2048 * 2;
constexpr size_t OFF_QR = OFF_VT + (size_t)2048 * NPT * 2;
constexpr size_t OFF_S = OFF_G;
constexpr size_t OFF_QLAT = OFF_WFF;
constexpr size_t OFF_CKVP = OFF_QLAT + (size_t)NTOK * 512 * 2;
constexpr size_t OFF_GA = OFF_G;
constexpr size_t OFF_OLAT = OFF_WD;
constexpr size_t OFF_POOLED = OFF_XN;
constexpr size_t OFF_MIXED = OFF_POOLED + (size_t)NTOK * 1024 * 2;
constexpr size_t OFF_P = OFF_WGU;
constexpr size_t OFF_MERGED = OFF_XN;
constexpr size_t OFF_QABS = OFF_WIN;
constexpr size_t OFF_WUKP = OFF_G + (size_t)84 * 1048576;
static_assert(OFF_WUKP >= OFF_QR + (size_t)NPT * 1024 * 2 && OFF_WUKP + (size_t)512 * 2048 * 2 <= OFF_G + SZ_G, "WUKP placement");
constexpr size_t OFF_SLABG = OFF_GATES;
constexpr size_t OFF_SLAB = OFF_GATES;
static_assert((size_t)8 * NST * DM * 4 <= (size_t)NTOK * 4096 * 2, "SLAB overflow");
static_assert(OFF_QR + (size_t)NPT * 1024 * 2 <= OFF_G + SZ_G, "G region overflow");
static_assert((size_t)16384 * 1056 * 4 <= SZ_G, "S overflow");
static_assert((size_t)1024 * 16 * 512 * 2 <= SZ_WD, "OLAT overflow");
static_assert((size_t)1024 * 16 * 640 * 2 <= (size_t)6400 * 2048 * 2, "QABS overflow");
static_assert((size_t)16384 * 1152 * 2 <= SZ_WGU, "P overflow");

constexpr size_t OUT_Y = 0;
constexpr size_t OUT_CKV_P = 18874368, OUT_KR_P = 23068672, OUT_POOL_P = 23592960, OUT_CKV_S = 23654400, OUT_KR_S = 24178688, OUT_POOL_S = 24244224;

struct Params {
    const float* in[26];
    float* out;
    unsigned char* ws;
    int ph_lo, ph_hi;
};

typedef __bf16 bf16x2_t __attribute__((ext_vector_type(2)));
typedef float f32x2_t __attribute__((ext_vector_type(2)));
DI unsigned cvt_pk_bf16(float lo, float hi) { const f32x2_t v = {lo, hi}; const bf16x2_t b = __builtin_convertvector(v, bf16x2_t); return __builtin_bit_cast(unsigned, b); }
DI float bf2f(unsigned short b) { return __uint_as_float(((unsigned)b) << 16); }
DI float bflo(unsigned w) { return __uint_as_float(w << 16); }
DI float bfhi(unsigned w) { return __uint_as_float(w & 0xffff0000u); }
DI int lane_id() { return (int)__builtin_amdgcn_mbcnt_hi(~0u, __builtin_amdgcn_mbcnt_lo(~0u, 0u)); }
#define TIDX (wv * 64 + lane_id())
DI f32x4 bf4(u32x2 w) { return (f32x4){bflo(w.x), bfhi(w.x), bflo(w.y), bfhi(w.y)}; }
DI float wave_sum(float v) {
#pragma unroll
    for (int o = 32; o > 0; o >>= 1) v += __shfl_xor(v, o);
    return v;
}
DI float wave_max(float v) {
#pragma unroll
    for (int o = 32; o > 0; o >>= 1) v = fmaxf(v, __shfl_xor(v, o));
    return v;
}
DI void rope_cs(int pos, int i, float& c, float& s) {
    const float inv = exp2f(-(float)i * 0.41524101186092029f);
    float rev = (float)pos * inv * 0.15915494309189535f;
    rev = rev - floorf(rev);
    s = __builtin_amdgcn_sinf(rev); c = __builtin_amdgcn_cosf(rev);
}
DI float silu_f(float g) { return g * __builtin_amdgcn_rcpf(1.0f + __builtin_amdgcn_exp2f(-1.4426950408889634f * g)); }
DI float sigmoid_f(float g) { return __builtin_amdgcn_rcpf(1.0f + __builtin_amdgcn_exp2f(-1.4426950408889634f * g)); }

namespace pg8 {
constexpr int BM = 256, BK = 64, HALF = 128, HTB = HALF * BK * 2, STAGE_BYTES = 8 * HTB, NXCD = 8, WGM = 8;
DI int lds_byte(int r, int c) { const int st = (r >> 4) * 2 + (c >> 5), rr = r & 15, cc = c & 31, ob = rr * 64 + cc * 2; return st * 1024 + (ob ^ (((ob >> 9) & 1) << 5)); }
DI void stage_rc(int b, int& R, int& C) { const int st = b / 1024, sb = b % 1024, swz = sb ^ (((sb >> 9) & 1) << 5); R = (st >> 1) * 16 + swz / 64; C = (st & 1) * 32 + (swz % 64) / 2; }
DI int perm32(int rho) { const int n = rho >> 4, i = rho & 15; return 8 * (i >> 2) + 4 * n + (i & 3); }

struct Unit { int pm, pn, bz, kt0, nkt, part; };
struct Gemm {
    const char* A; const char* B;
    int lda, ldb, K;
    int nM, nN, nB;
    long long a_ts, b_ts;
    long long a_bs, b_bs;
    int rot;
    int u0, u1, boff, nblk;
    int split;
};
DI void map_unit(int wgid, int nM, int nN, int nwg, int& pm, int& pn) {
    { const int q = nwg / NXCD, r = nwg % NXCD, xcd = wgid % NXCD, off = wgid / NXCD; wgid = (xcd < r ? xcd * (q + 1) : r * (q + 1) + (xcd - r) * q) + off; }
    const int nig = WGM * nN, gid = wgid / nig, fm = gid * WGM, gsz = (nM - fm) < WGM ? (nM - fm) : WGM;
    pm = fm + ((wgid % nig) % gsz); pn = (wgid % nig) / gsz;
}
struct Order {
    int nM, nN, nB, nwg, G, c, split, ntk, u0, u1;
    DI void init(const Gemm& g) { nM = g.nM; nN = g.nN; nB = g.nB; split = g.split; ntk = g.K / BK; if (split == 1) nM = 32; nwg = nM * nN * nB; u0 = 0; u1 = 0x7fffffff;
        if (g.nblk > 0) { u0 = g.u0; u1 = g.u1; G = g.nblk; c = (int)blockIdx.x - g.boff; if (c < 0 || c >= G) { u0 = 0; u1 = 0; c = 0; } return; } G = gridDim.x; c = (int)((blockIdx.x + (unsigned)g.rot) % gridDim.x); }
    DI bool next(int i, Unit& u) const {
        long L = (long)u0 + (long)i * G + c; if (L >= u1) return false;
        u.kt0 = 0; u.nkt = ntk; u.part = -1;
        if (split == 1 && L >= nwg) {
            L -= nwg; if (L >= 256) return false;
            const int kp = (int)(L & 7), t = (int)(L >> 3); u.pm = 32 + (t & 3); u.pn = t >> 2; u.bz = 0; u.part = kp;
            const int P = ntk >> 1, base = P >> 3, rem = P & 7; u.kt0 = 2 * (kp * base + (kp < rem ? kp : rem)); u.nkt = 2 * (base + (kp < rem ? 1 : 0));
            return true;
        }
        if (split == 2) {
            const int full = (nwg / G) * G, left = nwg - full;
            if (L >= full) { const int qd = (int)L - full; if (qd >= 4 * left) return false;
                map_unit(full + (qd >> 2), nM, nN, nwg, u.pm, u.pn); u.bz = qd >> 2; u.part = qd & 3; u.nkt = ntk >> 2; u.kt0 = u.part * u.nkt; return true; }
        }
        if (L >= nwg) return false;
        int wgid = (int)L;
        if (nB == 1) {
            map_unit(wgid, nM, nN, nwg, u.pm, u.pn); u.bz = 0;
        } else {
            const int per = nM * nN; u.bz = wgid / per; const int rem = wgid - u.bz * per; u.pm = rem % nM; u.pn = rem / nM;
        }
        return true;
    }
};

template <class Epi>
DI void gemm_phase(LAS unsigned char* lds, const Gemm g, const Epi& E, const int wv) {
    const int wid = wv, lane = lane_id(), tid = wid * 64 + lane, wr = wid >> 2, wc = wid & 3, fr = lane & 15, fq = lane >> 4;
    Order S; S.init(g);
    unsigned voffA[2], voffB[2];
#pragma unroll
    for (int i = 0; i < 2; ++i) { int R, C; stage_rc(tid * 16 + i * 8192, R, C); const int Rb = Epi::PERM ? ((R & ~31) + perm32(R & 31)) : R;
        voffA[i] = (unsigned)(R * g.lda + C) * 2u; voffB[i] = (unsigned)(Rb * g.ldb + C) * 2u; }
    const size_t kstep = (size_t)(BK * 2);
    const size_t hstepA = (size_t)HALF * g.lda * 2, hstepB = (size_t)HALF * g.ldb * 2;
    const unsigned ldsw = (unsigned)wid * 1024u;
    const int aoff = lds_byte(wr * 64 + fr, fq * 8), boff = lds_byte(wc * 32 + fr, fq * 8);
#define PG8_SA(b, h) (((b) * 2 + (h)) * HTB)
#define PG8_SB(b, h) ((4 + (b) * 2 + (h)) * HTB)
#define PG8_STAGE(bufoff, gbase, voff) do { _Pragma("unroll") for (int _i = 0; _i < 2; ++_i) \
        __builtin_amdgcn_global_load_lds((const unsigned*)((const char*)(gbase) + (voff)[_i]), (LAS unsigned*)(lds + (bufoff) + ldsw + _i * 8192), 16, 0, 0); } while (0)
#define PG8_LDA(dst, b, h) do { _Pragma("unroll") for (int m = 0; m < 4; ++m) _Pragma("unroll") for (int k = 0; k < 2; ++k) dst[m][k] = *(const LAS bf16x8*)(lds + PG8_SA(b, h) + aoff + m * 2048 + k * 1024); } while (0)
#define PG8_LDB(dst, b, h) do { _Pragma("unroll") for (int n = 0; n < 2; ++n) _Pragma("unroll") for (int k = 0; k < 2; ++k) dst[n][k] = *(const LAS bf16x8*)(lds + PG8_SB(b, h) + boff + n * 2048 + k * 1024); } while (0)
#define PG8_MMA(ai, bj, At, Bt) do { __builtin_amdgcn_s_setprio(1); _Pragma("unroll") for (int m = 0; m < 4; ++m) _Pragma("unroll") for (int n = 0; n < 2; ++n) _Pragma("unroll") for (int k = 0; k < 2; ++k) \
        acc[ai][bj][m][n] = __builtin_amdgcn_mfma_f32_16x16x32_bf16(Bt[n][k], At[m][k], acc[ai][bj][m][n], 0, 0, 0); __builtin_amdgcn_s_setprio(0); } while (0)
#define PG8_WAIT_V(n) asm volatile("s_waitcnt vmcnt(" #n ")" ::: "memory")
#define PG8_WAIT_L(n) asm volatile("s_waitcnt lgkmcnt(" #n ")" ::: "memory")
#define PG8_BAR __builtin_amdgcn_s_barrier()
#define PG8_SCHED __builtin_amdgcn_sched_barrier(0)
    Unit cur, nxt; int ui = 0;
    if (!S.next(0, cur)) return;
    f32x4 acc[2][2][4][2];
#pragma unroll
    for (int a = 0; a < 2; ++a)
#pragma unroll
        for (int b = 0; b < 2; ++b)
#pragma unroll
            for (int m = 0; m < 4; ++m)
#pragma unroll
                for (int n = 0; n < 2; ++n) acc[a][b][m][n] = (f32x4){0.f, 0.f, 0.f, 0.f};
    bf16x8 At[4][2], B0[2][2], B1[2][2];
    const char* cA = g.A + (size_t)cur.bz * g.a_bs + (size_t)cur.pm * g.a_ts + (size_t)cur.kt0 * kstep; const char* cB = g.B + (size_t)cur.bz * g.b_bs + (size_t)cur.pn * g.b_ts + (size_t)cur.kt0 * kstep;
    PG8_STAGE(PG8_SB(0, 0), cB, voffB); PG8_STAGE(PG8_SA(0, 0), cA, voffA); PG8_STAGE(PG8_SB(0, 1), cB + hstepB, voffB); PG8_STAGE(PG8_SA(0, 1), cA + hstepA, voffA);
    if (wr == 1) PG8_BAR;
    PG8_WAIT_V(4); PG8_BAR;
    PG8_STAGE(PG8_SB(1, 0), cB + kstep, voffB); PG8_STAGE(PG8_SA(1, 0), cA + kstep, voffA); PG8_STAGE(PG8_SB(1, 1), cB + hstepB + kstep, voffB);
    PG8_WAIT_V(6); PG8_BAR;
    for (;;) {
        const bool has_next = S.next(ui + 1, nxt);
        const char* nA = has_next ? g.A + (size_t)nxt.bz * g.a_bs + (size_t)nxt.pm * g.a_ts + (size_t)nxt.kt0 * kstep : cA; const char* nB = has_next ? g.B + (size_t)nxt.bz * g.b_bs + (size_t)nxt.pn * g.b_ts + (size_t)nxt.kt0 * kstep : cB;
        const int nt = cur.nkt;
        for (int t = 0; t < nt; t += 2) {
            const bool last = (t == nt - 2);
            const char* a1 = cA + (size_t)(t + 1) * kstep;
            const char* a2 = last ? nA : cA + (size_t)(t + 2) * kstep; const char* b2 = last ? nB : cB + (size_t)(t + 2) * kstep;
            const char* a3 = a2 + kstep; const char* b3 = b2 + kstep;
            PG8_LDB(B0, 0, 0); PG8_SCHED; PG8_LDA(At, 0, 0); PG8_STAGE(PG8_SA(1, 1), a1 + hstepA, voffA);
            PG8_WAIT_L(8); PG8_BAR; PG8_WAIT_L(0); PG8_MMA(0, 0, At, B0); PG8_BAR; PG8_SCHED;
            PG8_LDB(B1, 0, 1); PG8_STAGE(PG8_SB(0, 0), b2, voffB);
            PG8_BAR; PG8_WAIT_L(0); PG8_MMA(0, 1, At, B1); PG8_BAR;
            PG8_LDA(At, 0, 1); PG8_STAGE(PG8_SA(0, 0), a2, voffA);
            PG8_BAR; PG8_WAIT_L(0); PG8_MMA(1, 0, At, B0); PG8_BAR; PG8_SCHED;
            PG8_STAGE(PG8_SB(0, 1), b2 + hstepB, voffB);
            PG8_WAIT_V(6); PG8_BAR; PG8_MMA(1, 1, At, B1); PG8_BAR;
            PG8_LDB(B0, 1, 0); PG8_SCHED; PG8_LDA(At, 1, 0); PG8_STAGE(PG8_SA(0, 1), a2 + hstepA, voffA);
            PG8_WAIT_L(8); PG8_BAR; PG8_WAIT_L(0); PG8_MMA(0, 0, At, B0); PG8_BAR; PG8_SCHED;
            PG8_LDB(B1, 1, 1); PG8_STAGE(PG8_SB(1, 0), b3, voffB);
            PG8_BAR; PG8_WAIT_L(0); PG8_MMA(0, 1, At, B1); PG8_BAR;
            PG8_LDA(At, 1, 1); PG8_STAGE(PG8_SA(1, 0), a3, voffA);
            PG8_BAR; PG8_WAIT_L(0); PG8_MMA(1, 0, At, B0); PG8_BAR; PG8_SCHED;
            PG8_STAGE(PG8_SB(1, 1), b3 + hstepB, voffB);
            PG8_WAIT_V(6); PG8_BAR; PG8_MMA(1, 1, At, B1); PG8_BAR;
        }
        E(acc, cur, wr, wc, fr, fq);
        if (!has_next) break;
#pragma unroll
        for (int a = 0; a < 2; ++a)
#pragma unroll
            for (int b = 0; b < 2; ++b)
#pragma unroll
                for (int m = 0; m < 4; ++m)
#pragma unroll
                    for (int n = 0; n < 2; ++n) acc[a][b][m][n] = (f32x4){0.f, 0.f, 0.f, 0.f};
        cur = nxt; cA = nA; cB = nB; ++ui;
    }
    PG8_WAIT_V(0);
    if (wr == 0) PG8_BAR;
    PG8_BAR;
#undef PG8_SA
#undef PG8_SB
#undef PG8_STAGE
#undef PG8_LDA
#undef PG8_LDB
#undef PG8_MMA
#undef PG8_WAIT_V
#undef PG8_WAIT_L
#undef PG8_BAR
#undef PG8_SCHED
}

typedef f32x4 Acc[2][2][4][2];
#define EPI_ROWS  _Pragma("unroll") for (int ai = 0; ai < 2; ++ai) _Pragma("unroll") for (int m = 0; m < 4; ++m)

struct EpiSwiglu {
    static constexpr bool PERM = true;
    bf16_t* G; float* slab;
    DI void operator()(const Acc& acc, const Unit& u, int wr, int wc, int fr, int fq) const {
        if (u.part >= 0) {
            bf16_t* sp = (bf16_t*)slab + ((size_t)(u.bz * 4 + u.part) * 32 * 512 + (size_t)((wr * 4 + wc) * 64 + fq * 16 + fr)) * 4;
#pragma unroll
            for (int ai = 0; ai < 2; ++ai)
#pragma unroll
                for (int bj = 0; bj < 2; ++bj)
#pragma unroll
                    for (int m = 0; m < 4; ++m)
#pragma unroll
                        for (int n = 0; n < 2; ++n) { const f32x4 t = acc[ai][bj][m][n]; u32x2 w; w.x = cvt_pk_bf16(t[0], t[1]); w.y = cvt_pk_bf16(t[2], t[3]);
                            *(u32x2*)(sp + (size_t)(((ai * 2 + bj) * 4 + m) * 2 + n) * 2048) = w; }
            return;
        }
        const int row0 = u.pm * BM + wr * 64 + fr, col0 = u.pn * 128 + wc * 32 + 8 * fq;
        EPI_ROWS { bf16_t* rp = G + (size_t)(row0 + ai * HALF + m * 16) * DFF + col0;
            const f32x4 g0 = acc[ai][0][m][0], g1 = acc[ai][0][m][1], u0 = acc[ai][1][m][0], u1 = acc[ai][1][m][1];
            u32x4 w; w.x = cvt_pk_bf16(silu_f(g0[0]) * u0[0], silu_f(g0[1]) * u0[1]); w.y = cvt_pk_bf16(silu_f(g0[2]) * u0[2], silu_f(g0[3]) * u0[3]);
            w.z = cvt_pk_bf16(silu_f(g1[0]) * u1[0], silu_f(g1[1]) * u1[1]); w.w = cvt_pk_bf16(silu_f(g1[2]) * u1[2], silu_f(g1[3]) * u1[3]);
            *(u32x4*)rp = w; }
    }
};
struct EpiResid {
    static constexpr bool PERM = false;
    float* out; const float* resP; const float* resS; float scale; float* slab;
    const bf16_t* resB; bf16_t* outB;
    DI void operator()(const Acc& acc, const Unit& u, int wr, int wc, int fr, int fq) const {
        const int row0 = u.pm * BM + wr * 64 + fr, col0 = u.pn * BM + wc * 32 + 4 * fq;
        if (u.part >= 0) {
            EPI_ROWS { bf16_t* op = (bf16_t*)slab + ((size_t)u.part * NST + (size_t)(row0 + ai * HALF + m * 16 - NPT)) * DM + col0;
#pragma unroll
                for (int bj = 0; bj < 2; ++bj)
#pragma unroll
                    for (int n = 0; n < 2; ++n) { const f32x4 t = acc[ai][bj][m][n] * scale; u32x2 w; w.x = cvt_pk_bf16(t[0], t[1]); w.y = cvt_pk_bf16(t[2], t[3]); *(u32x2*)(op + bj * HALF + n * 16) = w; } }
            return;
        }
        const float* rb = (u.pm * BM < NPT ? resP : resS - (size_t)NPT * DM) + col0; float* ob = out + col0;
#define ER_ROW(b, mm) ((size_t)(row0 + ((b) >> 1) * HALF + (2 * ((b) & 1) + (mm)) * 16) * DM)
#define ER_LD(R, b) do { _Pragma("unroll") for (int mm = 0; mm < 2; ++mm) _Pragma("unroll") for (int bj = 0; bj < 2; ++bj) _Pragma("unroll") for (int n = 0; n < 2; ++n) { \
            if (resB != nullptr) { const u32x2 w_ = *(const u32x2*)(resB + ER_ROW(b, mm) + col0 + bj * HALF + n * 16); R[mm][bj][n] = (f32x4){__uint_as_float(w_.x), __uint_as_float(w_.y), 0.f, 0.f}; } \
            else R[mm][bj][n] = *(const f32x4*)(rb + ER_ROW(b, mm) + bj * HALF + n * 16); } } while (0)
#define ER_ST(R, b) do { _Pragma("unroll") for (int mm = 0; mm < 2; ++mm) _Pragma("unroll") for (int bj = 0; bj < 2; ++bj) _Pragma("unroll") for (int n = 0; n < 2; ++n) { \
            f32x4 r_ = R[mm][bj][n]; if (resB != nullptr) { const unsigned w0_ = __float_as_uint(r_[0]), w1_ = __float_as_uint(r_[1]); r_ = (f32x4){bflo(w0_), bfhi(w0_), bflo(w1_), bfhi(w1_)}; } \
            const f32x4 hv_ = r_ + acc[(b) >> 1][bj][2 * ((b) & 1) + mm][n] * scale; \
            if (outB != nullptr) { u32x2 w_; w_.x = cvt_pk_bf16(hv_[0], hv_[1]); w_.y = cvt_pk_bf16(hv_[2], hv_[3]); *(u32x2*)(outB + ER_ROW(b, mm) + col0 + bj * HALF + n * 16) = w_; } \
            else *(f32x4*)(ob + ER_ROW(b, mm) + bj * HALF + n * 16) = hv_; } } while (0)
        f32x4 ra[2][2][2], rc[2][2][2];
        ER_LD(ra, 0); ER_LD(rc, 1); ER_ST(ra, 0); ER_LD(ra, 2); ER_ST(rc, 1); ER_LD(rc, 3); ER_ST(ra, 2); ER_ST(rc, 3);
#undef ER_ROW
#undef ER_LD
#undef ER_ST
    }
};
struct EpiBf16 {
    static constexpr bool PERM = true;
    bf16_t* O; int ld; long long bs; float scale; int half_only;
    DI void operator()(const Acc& acc, const Unit& u, int wr, int wc, int fr, int fq) const {
        const int row0 = u.pm * BM + wr * 64 + fr, col0 = u.pn * (half_only ? 128 : BM) + wc * 32 + 8 * fq;
        bf16_t* base = O + (size_t)u.bz * bs;
        EPI_ROWS { bf16_t* rp = base + (size_t)(row0 + ai * HALF + m * 16) * ld + col0;
#pragma unroll
            for (int bj = 0; bj < 2; ++bj) { if (bj == 1 && half_only) continue;
                const f32x4 v0 = acc[ai][bj][m][0] * scale, v1 = acc[ai][bj][m][1] * scale;
                u32x4 w; w.x = cvt_pk_bf16(v0[0], v0[1]); w.y = cvt_pk_bf16(v0[2], v0[3]); w.z = cvt_pk_bf16(v1[0], v1[1]); w.w = cvt_pk_bf16(v1[2], v1[3]);
                *(u32x4*)(rp + bj * HALF) = w; } }
    }
};
struct EpiScore {
    static constexpr bool PERM = false;
    _Float16* S;
    DI void operator()(const Acc& acc, const Unit& u, int wr, int wc, int fr, int fq) const {
        const int row0 = u.bz * 512 + u.pm * BM + wr * 64 + fr, col0 = u.pn * BM + wc * 32 + 4 * fq;
        EPI_ROWS { _Float16* op = S + (size_t)(row0 + ai * HALF + m * 16) * 1056 + col0;
#pragma unroll
            for (int bj = 0; bj < 2; ++bj)
#pragma unroll
                for (int n = 0; n < 2; ++n) { if (col0 + bj * HALF + n * 16 < 1056) *(u32x2*)(op + bj * HALF + n * 16) = __builtin_bit_cast(u32x2, __builtin_convertvector(acc[ai][bj][m][n], f16x4)); } }
    }
};
struct EpiWin {
    static constexpr bool PERM = true;
    float* Z; float* QLR; float* CKR; bf16_t* GATES; bf16_t* KRB; float* outKrP; float* outKrS; float* outPoolP; float* outPoolS;
    DI void operator()(const Acc& acc, const Unit& u, int wr, int wc, int fr, int fq) const {
        const int row0 = u.pm * BM + wr * 64 + fr, cw = wc * 32 + 8 * fq;
        if (u.pn < 6) {
            bf16_t* base; int ld, c0;
            if (u.pn < 4) { base = (bf16_t*)Z; ld = 1024; c0 = u.pn * 256; } else { base = (bf16_t*)QLR; ld = 512; c0 = (u.pn - 4) * 256; }
            EPI_ROWS { const int row = row0 + ai * HALF + m * 16; bf16_t* op = base + (size_t)row * ld + c0 + cw;
#pragma unroll
                for (int bj = 0; bj < 2; ++bj) { const f32x4 v0 = acc[ai][bj][m][0], v1 = acc[ai][bj][m][1];
                    u32x4 w; w.x = cvt_pk_bf16(v0[0], v0[1]); w.y = cvt_pk_bf16(v0[2], v0[3]); w.z = cvt_pk_bf16(v1[0], v1[1]); w.w = cvt_pk_bf16(v1[2], v1[3]);
                    *(u32x4*)(op + bj * HALF) = w; }
                if (u.pn < 4) {
                    float* pf = nullptr;
                    if (row < NPT) { const int t = row & 2047; if (t >= 2033) pf = outPoolP + ((size_t)(row >> 11) * 15 + (t - 2033)) * 1024; }
                    else { const int rs = row - NPT, t = rs & 31; if (t >= 17) pf = outPoolS + ((size_t)(rs >> 5) * 15 + (t - 17)) * 1024; }
                    if (pf != nullptr) {
#pragma unroll
                        for (int bj = 0; bj < 2; ++bj) { *(f32x4*)(pf + c0 + cw + bj * HALF) = acc[ai][bj][m][0]; *(f32x4*)(pf + c0 + cw + bj * HALF + 4) = acc[ai][bj][m][1]; } } } }
        } else if (u.pn < 8) {
            const int c0 = (u.pn - 6) * 256;
            EPI_ROWS { float* op = CKR + (size_t)(row0 + ai * HALF + m * 16) * 512 + c0 + cw;
#pragma unroll
                for (int bj = 0; bj < 2; ++bj) { *(f32x4*)(op + bj * HALF) = acc[ai][bj][m][0]; *(f32x4*)(op + bj * HALF + 4) = acc[ai][bj][m][1]; } }
        } else if (u.pn < 24) {
            const int c0 = (u.pn - 8) * 256 + cw;
            EPI_ROWS { bf16_t* op = GATES + (size_t)(row0 + ai * HALF + m * 16) * 4096 + c0;
#pragma unroll
                for (int bj = 0; bj < 2; ++bj) { const f32x4 v0 = acc[ai][bj][m][0], v1 = acc[ai][bj][m][1];
                    u32x4 w; w.x = cvt_pk_bf16(sigmoid_f(v0[0]), sigmoid_f(v0[1])); w.y = cvt_pk_bf16(sigmoid_f(v0[2]), sigmoid_f(v0[3]));
                    w.z = cvt_pk_bf16(sigmoid_f(v1[0]), sigmoid_f(v1[1])); w.w = cvt_pk_bf16(sigmoid_f(v1[2]), sigmoid_f(v1[3]));
                    *(u32x4*)(op + bj * HALF) = w; } }
        } else if (wc == 0) {
            EPI_ROWS { const int row = row0 + ai * HALF + m * 16;
                const int pos = row < NPT ? (row & 2047) : 1024 + ((row - NPT) & 31);
                float* of = row < NPT ? outKrP + (size_t)row * 64 : outKrS + (size_t)(row - NPT) * 64;
                bf16_t* ob = KRB + (size_t)row * 64;
                float o1[8], o2[8];
#pragma unroll
                for (int n = 0; n < 2; ++n)
#pragma unroll
                    for (int j = 0; j < 4; ++j) { float c, s; rope_cs(pos, 8 * fq + 4 * n + j, c, s); const float x1 = acc[ai][0][m][n][j], x2 = acc[ai][1][m][n][j];
                        o1[4 * n + j] = x1 * c - x2 * s; o2[4 * n + j] = x2 * c + x1 * s; }
                *(f32x4*)(of + 8 * fq) = (f32x4){o1[0], o1[1], o1[2], o1[3]}; *(f32x4*)(of + 8 * fq + 4) = (f32x4){o1[4], o1[5], o1[6], o1[7]};
                *(f32x4*)(of + 32 + 8 * fq) = (f32x4){o2[0], o2[1], o2[2], o2[3]}; *(f32x4*)(of + 32 + 8 * fq + 4) = (f32x4){o2[4], o2[5], o2[6], o2[7]};
                u32x4 w1, w2; w1.x = cvt_pk_bf16(o1[0], o1[1]); w1.y = cvt_pk_bf16(o1[2], o1[3]); w1.z = cvt_pk_bf16(o1[4], o1[5]); w1.w = cvt_pk_bf16(o1[6], o1[7]);
                w2.x = cvt_pk_bf16(o2[0], o2[1]); w2.y = cvt_pk_bf16(o2[2], o2[3]); w2.z = cvt_pk_bf16(o2[4], o2[5]); w2.w = cvt_pk_bf16(o2[6], o2[7]);
                *(u32x4*)(ob + 8 * fq) = w1; *(u32x4*)(ob + 32 + 8 * fq) = w2; }
        }
    }
};
struct EpiQ {
    static constexpr bool PERM = true;
    bf16_t* QN; bf16_t* QR; bf16_t* QABS;
    DI void operator()(const Acc& acc, const Unit& u, int wr, int wc, int fr, int fq) const {
        const int row0 = u.pm * BM + wr * 64 + fr;
        if (u.pn < 8) {
            const int col0 = u.pn * BM + wc * 32 + 8 * fq;
            EPI_ROWS { bf16_t* rp = QN + (size_t)(row0 + ai * HALF + m * 16) * 2048 + col0;
#pragma unroll
                for (int bj = 0; bj < 2; ++bj) { const f32x4 v0 = acc[ai][bj][m][0] * QSCALE, v1 = acc[ai][bj][m][1] * QSCALE;
                    u32x4 w; w.x = cvt_pk_bf16(v0[0], v0[1]); w.y = cvt_pk_bf16(v0[2], v0[3]); w.z = cvt_pk_bf16(v1[0], v1[1]); w.w = cvt_pk_bf16(v1[2], v1[3]);
                    *(u32x4*)(rp + bj * HALF) = w; } }
        } else {
            const int head = 4 * (u.pn - 8) + wc;
            EPI_ROWS { const int row = row0 + ai * HALF + m * 16;
                const int pos = row < NPT ? (row & 2047) : 1024 + ((row - NPT) & 31);
                float o1[8], o2[8];
#pragma unroll
                for (int n = 0; n < 2; ++n)
#pragma unroll
                    for (int j = 0; j < 4; ++j) { float c, s; rope_cs(pos, 8 * fq + 4 * n + j, c, s); const float x1 = acc[ai][0][m][n][j] * QSCALE, x2 = acc[ai][1][m][n][j] * QSCALE;
                        o1[4 * n + j] = x1 * c - x2 * s; o2[4 * n + j] = x2 * c + x1 * s; }
                u32x4 w1, w2; w1.x = cvt_pk_bf16(o1[0], o1[1]); w1.y = cvt_pk_bf16(o1[2], o1[3]); w1.z = cvt_pk_bf16(o1[4], o1[5]); w1.w = cvt_pk_bf16(o1[6], o1[7]);
                w2.x = cvt_pk_bf16(o2[0], o2[1]); w2.y = cvt_pk_bf16(o2[2], o2[3]); w2.z = cvt_pk_bf16(o2[4], o2[5]); w2.w = cvt_pk_bf16(o2[6], o2[7]);
                if (row < NPT) { bf16_t* ob = QR + (size_t)row * 1024 + head * 64; *(u32x4*)(ob + 8 * fq) = w1; *(u32x4*)(ob + 32 + 8 * fq) = w2; }
                else { bf16_t* ob = QABS + ((size_t)(row - NPT) * 16 + head) * 640 + 512; const u32x4 z = (u32x4){0u, 0u, 0u, 0u};
                    *(u32x4*)(ob + 8 * fq) = w1; *(u32x4*)(ob + 32 + 8 * fq) = w2; *(u32x4*)(ob + 64 + 8 * fq) = z; *(u32x4*)(ob + 96 + 8 * fq) = z; } }
        }
    }
};
struct EpiPoolMix {
    static constexpr bool PERM = true;
    bf16_t* MIXED; const float* pscale;
    DI void operator()(const Acc& acc, const Unit& u, int wr, int wc, int fr, int fq) const {
        const int row0 = u.pm * BM + wr * 64 + fr, col0 = u.bz * 256 + wc * 32 + 8 * fq;
        f32x4 sc[2][2];
#pragma unroll
        for (int bj = 0; bj < 2; ++bj) { sc[bj][0] = *(const f32x4*)(pscale + col0 + bj * HALF); sc[bj][1] = *(const f32x4*)(pscale + col0 + bj * HALF + 4); }
        EPI_ROWS { bf16_t* rp = MIXED + (size_t)(row0 + ai * HALF + m * 16) * 1024 + col0;
#pragma unroll
            for (int bj = 0; bj < 2; ++bj) { const f32x4 v0 = acc[ai][bj][m][0] * sc[bj][0], v1 = acc[ai][bj][m][1] * sc[bj][1];
                u32x4 w; w.x = cvt_pk_bf16(v0[0], v0[1]); w.y = cvt_pk_bf16(v0[2], v0[3]); w.z = cvt_pk_bf16(v1[0], v1[1]); w.w = cvt_pk_bf16(v1[2], v1[3]);
                *(u32x4*)(rp + bj * HALF) = w; } }
    }
};
struct EpiGate {
    static constexpr bool PERM = true;
    bf16_t* OUT; const bf16_t* GATES; const bf16_t* ADD; int goff; int mode;
    DI void operator()(const Acc& acc, const Unit& u, int wr, int wc, int fr, int fq) const {
        const int row0 = u.pm * BM + wr * 64 + fr, col0 = u.pn * BM + wc * 32 + 8 * fq;
#define EG_ROW(b, mm) ((size_t)(row0 + ((b) >> 1) * HALF + (2 * ((b) & 1) + (mm)) * 16))
#define EG_LD(GW, AW, b) do { _Pragma("unroll") for (int mm = 0; mm < 2; ++mm) _Pragma("unroll") for (int bj = 0; bj < 2; ++bj) { const int c = col0 + bj * HALF; \
            GW[mm][bj] = *(const u32x4*)(GATES + EG_ROW(b, mm) * 4096 + goff + c); AW[mm][bj] = (u32x4){0u, 0u, 0u, 0u}; if (mode) AW[mm][bj] = *(const u32x4*)(ADD + EG_ROW(b, mm) * 2048 + c); } } while (0)
#define EG_ST(GW, AW, b) do { _Pragma("unroll") for (int mm = 0; mm < 2; ++mm) _Pragma("unroll") for (int bj = 0; bj < 2; ++bj) { const int c = col0 + bj * HALF; \
            const u32x4 gw = GW[mm][bj], aw = AW[mm][bj]; const f32x4 a0 = acc[(b) >> 1][bj][2 * ((b) & 1) + mm][0], a1 = acc[(b) >> 1][bj][2 * ((b) & 1) + mm][1]; \
            u32x4 w; w.x = cvt_pk_bf16(bflo(aw.x) + bflo(gw.x) * a0[0], bfhi(aw.x) + bfhi(gw.x) * a0[1]); w.y = cvt_pk_bf16(bflo(aw.y) + bflo(gw.y) * a0[2], bfhi(aw.y) + bfhi(gw.y) * a0[3]); \
            w.z = cvt_pk_bf16(bflo(aw.z) + bflo(gw.z) * a1[0], bfhi(aw.z) + bfhi(gw.z) * a1[1]); w.w = cvt_pk_bf16(bflo(aw.w) + bflo(gw.w) * a1[2], bfhi(aw.w) + bfhi(gw.w) * a1[3]); \
            *(u32x4*)(OUT + EG_ROW(b, mm) * 2048 + c) = w; } } while (0)
        u32x4 ga[2][2], aa[2][2], gb[2][2], ab[2][2];
        EG_LD(ga, aa, 0); EG_LD(gb, ab, 1); EG_ST(ga, aa, 0); EG_LD(ga, aa, 2); EG_ST(gb, ab, 1); EG_LD(gb, ab, 3); EG_ST(ga, aa, 2); EG_ST(gb, ab, 3);
#undef EG_ROW
#undef EG_LD
#undef EG_ST
    }
};
}

template <int MAP> DI int maprow(int n) {
    if (MAP == 1) return 256 * (n >> 7) + (n & 127);
    if (MAP == 2) return 256 * (n >> 7) + 128 + (n & 127);
    if (MAP == 3) { if (n < 2048) return n; if (n < 2112) { const int i = n - 2048; return 6144 + (i >> 5) * 128 + (i & 31); } return n - 64; }
    if (MAP == 4) { const int h = n / 192, d = n - h * 192; if (d < 128) return h * 128 + d; const int i = d - 128; return 256 * (8 + (h >> 2)) + (i >> 5) * 128 + (h & 3) * 32 + (i & 31); }
    return n;
}
template <int MAP> DI void convT(const float* __restrict__ src, int ldsrc, int K, int N, bf16_t* __restrict__ dst, int ldd, float* sm, int blk, int nblk, const int wv) {
    const int tid = TIDX, ntk = K >> 7, ntn = N >> 6, ntile = ntk * ntn;
    const int rr = tid >> 4, c4 = (tid & 15) * 4;
    f32x4 v[4], n1[4], n2[4];
#define CT_LOAD(dstv, t) do { const int kt_ = (t) % ntk, nt_ = (t) / ntk; const float* sp_ = src + (size_t)(kt_ * 128 + rr) * ldsrc + nt_ * 64 + c4; \
        _Pragma("unroll") for (int q = 0; q < 4; ++q) dstv[q] = *(const f32x4*)(sp_ + (size_t)(32 * q) * ldsrc); } while (0)
    int tile = blk;
    if (tile < ntile) CT_LOAD(v, tile);
    if (tile + nblk < ntile) CT_LOAD(n1, tile + nblk);
    for (; tile < ntile; tile += nblk) {
        const int kt = tile % ntk, nt = tile / ntk;
        if (tile + 2 * nblk < ntile) CT_LOAD(n2, tile + 2 * nblk);
#pragma unroll
        for (int q = 0; q < 4; ++q)
#pragma unroll
            for (int e = 0; e < 4; ++e) sm[(c4 + e) * 132 + rr + 32 * q] = v[q][e];
        __syncthreads();
#pragma unroll
        for (int u = 0; u < 2; ++u) { const int id = tid + 512 * u, wn = id >> 4, k8 = (id & 15) * 8;
            const f32x4 a = *(const f32x4*)(sm + wn * 132 + k8), b = *(const f32x4*)(sm + wn * 132 + k8 + 4);
            u32x4 w; w.x = cvt_pk_bf16(a[0], a[1]); w.y = cvt_pk_bf16(a[2], a[3]); w.z = cvt_pk_bf16(b[0], b[1]); w.w = cvt_pk_bf16(b[2], b[3]);
            *(u32x4*)(dst + (size_t)maprow<MAP>(nt * 64 + wn) * ldd + kt * 128 + k8) = w; }
        __syncthreads();
#pragma unroll
        for (int q = 0; q < 4; ++q) { v[q] = n1[q]; n1[q] = n2[q]; }
    }
#undef CT_LOAD
}
DI void rmsnorm_rows_bf16(const float* srcP, const float* srcS, const float* __restrict__ gain, bf16_t* dst, const float* slab, float* hS, const int wv, const bf16_t* srcPB = nullptr) {
    const int lane = lane_id(), gw = blockIdx.x * 8 + wv, nw = gridDim.x * 8;
    for (int r = gw; r < NTOK; r += nw) {
        const float* sp = (r < NPT ? srcP + (size_t)r * DM : srcS + (size_t)(r - NPT) * DM);
        f32x4 v[8]; float ss = 0.f;
        if (srcPB != nullptr && r < NPT) {
#pragma unroll
            for (int i = 0; i < 8; ++i) { const u32x2 w = *(const u32x2*)(srcPB + (size_t)r * DM + i * 256 + lane * 4); v[i] = (f32x4){bflo(w.x), bfhi(w.x), bflo(w.y), bfhi(w.y)}; }
        } else {
#pragma unroll
            for (int i = 0; i < 8; ++i) v[i] = *(const f32x4*)(sp + i * 256 + lane * 4);
        }
        if (slab != nullptr && r >= NPT) {
#pragma unroll
            for (int sidx = 0; sidx < 8; ++sidx) { const bf16_t* sl = (const bf16_t*)slab + ((size_t)sidx * NST + (r - NPT)) * DM;
#pragma unroll
                for (int i = 0; i < 8; ++i) { const u32x2 w = *(const u32x2*)(sl + i * 256 + lane * 4); v[i] += (f32x4){bflo(w.x), bfhi(w.x), bflo(w.y), bfhi(w.y)}; } }
#pragma unroll
            for (int i = 0; i < 8; ++i) *(f32x4*)(hS + (size_t)(r - NPT) * DM + i * 256 + lane * 4) = v[i];
        }
#pragma unroll
        for (int i = 0; i < 8; ++i) ss += v[i][0] * v[i][0] + v[i][1] * v[i][1] + v[i][2] * v[i][2] + v[i][3] * v[i][3];
        ss = wave_sum(ss); const float rstd = rsqrtf(ss * (1.0f / 2048.0f) + 1e-6f);
#pragma unroll
        for (int i = 0; i < 8; ++i) { const f32x4 g = *(const f32x4*)(gain + i * 256 + lane * 4);
            u32x2 w; w.x = cvt_pk_bf16(v[i][0] * rstd * g[0], v[i][1] * rstd * g[1]); w.y = cvt_pk_bf16(v[i][2] * rstd * g[2], v[i][3] * rstd * g[3]);
            *(u32x2*)(dst + (size_t)r * DM + i * 256 + lane * 4) = w; }
    }
}
DI void convert_ffn_weights(const Params& p, unsigned char* ws, int layer, float* sm, const int bi, const int nb, const int wv, const int which = 3) {
    const float* wg = p.in[layer ? 22 : 6]; const float* wu = p.in[layer ? 23 : 7]; const float* wd = p.in[layer ? 24 : 8];
    if (which & 1) { convT<1>(wg, DFF, 2048, DFF, (bf16_t*)(ws + OFF_WGU), 2048, sm, bi, nb, wv);
        convT<2>(wu, DFF, 2048, DFF, (bf16_t*)(ws + OFF_WGU), 2048, sm, bi, nb, wv); }
    if (which & 2) convT<0>(wd, 2048, DFF, 2048, (bf16_t*)(ws + OFF_WD), DFF, sm, bi, nb, wv);
}

DI void convert_other_weights(const Params& p, unsigned char* ws, float* smf, const int bi, const int nb, const int wv) {
            convT<3>(p.in[10], 6208, 2048, 6208, (bf16_t*)(ws + OFF_WIN), 2048, smf, bi, nb, wv);
            convT<4>(p.in[13], 3072, 512, 3072, (bf16_t*)(ws + OFF_WUQ), 512, smf, (bi + 64) % nb, nb, wv);
            convT<0>(p.in[14], 2048, 512, 2048, (bf16_t*)(ws + OFF_WUKT), 512, smf, (bi + 192) % nb, nb, wv);
            convT<0>(p.in[15], 2048, 512, 2048, (bf16_t*)(ws + OFF_WUVT), 512, smf, bi, nb, wv);
            convT<0>(p.in[16], 2048, 2048, 2048, (bf16_t*)(ws + OFF_WOA), 2048, smf, bi, nb, wv);
            for (int g = 0; g < 4; ++g) convT<0>(p.in[17] + (size_t)g * 65536, 256, 256, 256, (bf16_t*)(ws + OFF_WPOOL) + (size_t)g * 65536, 256, smf, (bi + 16 * g) % nb, nb, wv);
            convT<0>(p.in[19], 2048, 1024, 2048, (bf16_t*)(ws + OFF_WPO), 1024, smf, (bi + 64) % nb, nb, wv);
            convT<0>(p.in[20], 2048, 2048, 2048, (bf16_t*)(ws + OFF_WOUT), 2048, smf, bi, nb, wv);
            {
                bf16_t* z = (bf16_t*)(ws + OFF_WUVT) + (size_t)2048 * 512;
                for (int i = bi * 512 + TIDX; i < 128 * 512 / 8; i += nb * 512) *(u32x4*)(z + (size_t)i * 8) = (u32x4){0u, 0u, 0u, 0u};
            }
}

DI void phase_token_local(const Params& p, unsigned char* ws, float* sm, const int wv) {
    const int lane = lane_id(), gw = blockIdx.x * 8 + wv, nw = gridDim.x * 8;
    const float* Z = (const float*)(ws + OFF_Z); const float* QLR = (const float*)(ws + OFF_QLR); const float* CKR = (const float*)(ws + OFF_CKR);
    bf16_t* QLAT = (bf16_t*)(ws + OFF_QLAT); bf16_t* CKVP = (bf16_t*)(ws + OFF_CKVP); bf16_t* POOLED = (bf16_t*)(ws + OFF_POOLED);
    bf16_t* KALL = (bf16_t*)(ws + OFF_KALL); bf16_t* CKVT = (bf16_t*)(ws + OFF_CKVT); const bf16_t* KRB = (const bf16_t*)(ws + OFF_KRB);
    const float* gq = p.in[11]; const float* gkv = p.in[12]; const float* spool = p.in[4];
    for (int r = gw; r < NTOK; r += nw) {
        const bool smp = r >= NPT; const int b = smp ? (r - NPT) >> 5 : r >> 11, t = smp ? (r - NPT) & 31 : r & 2047;
        const u32x4 qw = *(const u32x4*)((const bf16_t*)QLR + (size_t)r * 512 + lane * 8); const f32x4 qa = bf4((u32x2){qw.x, qw.y}), qc = bf4((u32x2){qw.z, qw.w});
        const float* cp = CKR + (size_t)r * 512 + lane * 8; f32x4 ca = *(const f32x4*)cp, cc = *(const f32x4*)(cp + 4);
        f32x4 self[4], pv[4];
#pragma unroll
        for (int g = 0; g < 4; ++g) self[g] = bf4(*(const u32x2*)((const bf16_t*)Z + (size_t)r * 1024 + 256 * g + 4 * lane));
#pragma unroll
        for (int g = 0; g < 4; ++g) {
            const int w = 2 << g, c = 256 * g + 4 * lane;
            f32x4 s = self[g];
            for (int j = 1; j < w; ++j) { const int tt = t - j;
                if (tt >= 0) s += bf4(*(const u32x2*)((const bf16_t*)Z + (size_t)(r - j) * 1024 + c));
                else if (smp) s += *(const f32x4*)(spool + ((size_t)b * 15 + 15 + tt) * 1024 + c); }
            const float cnt = smp ? (float)w : (float)(t + 1 < w ? t + 1 : w);
            pv[g] = s * (1.0f / cnt) - self[g];
        }
        float ssq = qa[0] * qa[0] + qa[1] * qa[1] + qa[2] * qa[2] + qa[3] * qa[3] + qc[0] * qc[0] + qc[1] * qc[1] + qc[2] * qc[2] + qc[3] * qc[3];
        float ssc = ca[0] * ca[0] + ca[1] * ca[1] + ca[2] * ca[2] + ca[3] * ca[3] + cc[0] * cc[0] + cc[1] * cc[1] + cc[2] * cc[2] + cc[3] * cc[3];
        ssq = wave_sum(ssq); ssc = wave_sum(ssc);
        const float rq = rsqrtf(ssq * (1.0f / 512.0f) + 1e-6f), rc = rsqrtf(ssc * (1.0f / 512.0f) + 1e-6f);
        const f32x4 gq0 = *(const f32x4*)(gq + lane * 8), gq1 = *(const f32x4*)(gq + lane * 8 + 4), gk0 = *(const f32x4*)(gkv + lane * 8), gk1 = *(const f32x4*)(gkv + lane * 8 + 4);
        u32x4 krw = (u32x4){0u, 0u, 0u, 0u}; if (smp && lane < 8) krw = *(const u32x4*)(KRB + (size_t)r * 64 + lane * 8);
        {   u32x4 w; w.x = cvt_pk_bf16(qa[0] * rq * gq0[0], qa[1] * rq * gq0[1]); w.y = cvt_pk_bf16(qa[2] * rq * gq0[2], qa[3] * rq * gq0[3]);
            w.z = cvt_pk_bf16(qc[0] * rq * gq1[0], qc[1] * rq * gq1[1]); w.w = cvt_pk_bf16(qc[2] * rq * gq1[2], qc[3] * rq * gq1[3]);
            *(u32x4*)(QLAT + (size_t)r * 512 + lane * 8) = w; }
        {   ca = ca * rc * gk0; cc = cc * rc * gk1;
            float* of = smp ? p.out + OUT_CKV_S + (size_t)(r - NPT) * 512 : p.out + OUT_CKV_P + (size_t)r * 512;
            *(f32x4*)(of + lane * 8) = ca; *(f32x4*)(of + lane * 8 + 4) = cc;
            u32x4 w; w.x = cvt_pk_bf16(ca[0], ca[1]); w.y = cvt_pk_bf16(ca[2], ca[3]); w.z = cvt_pk_bf16(cc[0], cc[1]); w.w = cvt_pk_bf16(cc[2], cc[3]);
            if (!smp) *(u32x4*)(CKVP + (size_t)r * 512 + lane * 8) = w;
            else {
                bf16_t* kr = KALL + ((size_t)b * 1056 + 1024 + t) * 640;
                *(u32x4*)(kr + lane * 8) = w;
                if (lane < 16) *(u32x4*)(kr + 512 + lane * 8) = krw;
                bf16_t* ct = CKVT + ((size_t)b * 512 + lane * 8) * 1152 + 1024 + t;
                ct[0] = (bf16_t)(w.x & 0xffff); ct[1152] = (bf16_t)(w.x >> 16); ct[2 * 1152] = (bf16_t)(w.y & 0xffff); ct[3 * 1152] = (bf16_t)(w.y >> 16);
                ct[4 * 1152] = (bf16_t)(w.z & 0xffff); ct[5 * 1152] = (bf16_t)(w.z >> 16); ct[6 * 1152] = (bf16_t)(w.w & 0xffff); ct[7 * 1152] = (bf16_t)(w.w >> 16);
            } }
#pragma unroll
        for (int g = 0; g < 4; ++g) { const int c = 256 * g + 4 * lane;
            u32x2 o; o.x = cvt_pk_bf16(pv[g][0], pv[g][1]); o.y = cvt_pk_bf16(pv[g][2], pv[g][3]);
            *(u32x2*)(POOLED + (size_t)r * 1024 + c) = o;
            }
    }
}

DI void convert_cache(const Params& p, unsigned char* ws, float* sm, const int bi, const int nb, const int wv) {
    const int lane = lane_id(), gw = bi * 8 + wv, nw = nb * 8;
    bf16_t* KALL = (bf16_t*)(ws + OFF_KALL); bf16_t* CKVT = (bf16_t*)(ws + OFF_CKVT);
    const float* cckv = p.in[2]; const float* ckr = p.in[3];
    for (int r0 = gw; r0 < 32 * 1024; r0 += 4 * nw) {
        f32x4 a[4], c[4], e[4], f[4];
#pragma unroll
        for (int k = 0; k < 4; ++k) { const int rr = r0 + k * nw;
            if (rr < 32 * 1024) { const float* sp = cckv + (size_t)rr * 512 + lane * 8; a[k] = *(const f32x4*)sp; c[k] = *(const f32x4*)(sp + 4);
                if (lane < 8) { const float* s2 = ckr + (size_t)rr * 64 + lane * 8; e[k] = *(const f32x4*)s2; f[k] = *(const f32x4*)(s2 + 4); } } }
#pragma unroll
        for (int k = 0; k < 4; ++k) { const int rr = r0 + k * nw;
            if (rr < 32 * 1024) { const int b = rr >> 10, key = rr & 1023;
                u32x4 w; w.x = cvt_pk_bf16(a[k][0], a[k][1]); w.y = cvt_pk_bf16(a[k][2], a[k][3]); w.z = cvt_pk_bf16(c[k][0], c[k][1]); w.w = cvt_pk_bf16(c[k][2], c[k][3]);
                bf16_t* kr = KALL + ((size_t)b * 1056 + key) * 640;
                *(u32x4*)(kr + lane * 8) = w;
                if (lane < 8) { u32x4 w2; w2.x = cvt_pk_bf16(e[k][0], e[k][1]); w2.y = cvt_pk_bf16(e[k][2], e[k][3]); w2.z = cvt_pk_bf16(f[k][0], f[k][1]); w2.w = cvt_pk_bf16(f[k][2], f[k][3]);
                    *(u32x4*)(kr + 512 + lane * 8) = w2; }
                else if (lane < 16) *(u32x4*)(kr + 512 + lane * 8) = (u32x4){0u, 0u, 0u, 0u}; } }
    }
    for (int b = 0; b < 32; ++b)
        convT<0>(cckv + (size_t)b * 1024 * 512, 512, 1024, 512, CKVT + (size_t)b * 512 * 1152, 1152, sm, (bi + b * 8) % nb, nb, wv);
    for (int i = bi * 512 + TIDX; i < 32 * 512 * 12; i += nb * 512) { const int row = i / 12, part = i - row * 12;
        *(u32x4*)(CKVT + (size_t)row * 1152 + 1056 + part * 8) = (u32x4){0u, 0u, 0u, 0u}; }
}

constexpr int ATT_KN = 0, ATT_KR = 16384, ATT_V = 24576, ATT_BUF = 40960;
#define MFMA32(a, b, c) __builtin_amdgcn_mfma_f32_32x32x16_bf16((a), (b), (c), 0, 0, 0)
DI void attn_item(unsigned char* ws, LAS unsigned char* lds, int b, int h, int qt, const int wv) {
    const int wid = wv, lane = lane_id(), tid = wid * 64 + lane, q = lane & 31, g = lane >> 5;
    const bf16_t* QN = (const bf16_t*)(ws + OFF_QN); const bf16_t* QR = (const bf16_t*)(ws + OFF_QR);
    const unsigned char* KN = ws + OFF_KN; const unsigned char* KRB = ws + OFF_KRB; const unsigned char* VT = ws + OFF_VT;
    const int qrow = b * 2048 + qt * 256 + wid * 32 + q;
    bf16x8 qf[12];
    { const bf16_t* qn = QN + (size_t)qrow * 2048 + h * 128 + 8 * g;
#pragma unroll
      for (int s = 0; s < 8; ++s) qf[s] = *(const bf16x8*)(qn + 16 * s);
      const bf16_t* qr = QR + (size_t)qrow * 1024 + h * 64 + 8 * g;
#pragma unroll
      for (int s = 0; s < 4; ++s) qf[8 + s] = *(const bf16x8*)(qr + 16 * s); }
    f32x16 o[4];
#pragma unroll
    for (int d = 0; d < 4; ++d)
#pragma unroll
        for (int i = 0; i < 16; ++i) o[d][i] = 0.f;
    float mrun = -1e30f, lrun = 0.f;
    const int ntiles = 4 * qt + 4, my_last = 4 * qt + (wid >> 1);
    const size_t tok0 = (size_t)b * 2048;
    const int knr = 8 * wid + (lane >> 4), knc = (lane & 15) ^ (knr & 15);
    const int knr1 = knr + 4, knc1 = (lane & 15) ^ (knr1 & 15);
    const int krr = 8 * wid + (lane >> 3), krc = (lane & 7) ^ ((krr >> 1) & 7);
    const int vr = 16 * wid + (lane >> 3), vc = (lane & 7) ^ ((vr >> 1) & 7);
    const int vr1 = vr + 8, vc1 = (lane & 7) ^ ((vr1 >> 1) & 7);
    const unsigned okn0 = (unsigned)(tok0 + knr) * 4096u + h * 256 + knc * 16, okn1 = (unsigned)(tok0 + knr1) * 4096u + h * 256 + knc1 * 16;
    const unsigned okr = (unsigned)(tok0 + krr) * 128u + krc * 16;
    const unsigned ov0 = ((unsigned)(h * 128 + vr) * 8192u + (unsigned)tok0) * 2u + vc * 16, ov1 = ((unsigned)(h * 128 + vr1) * 8192u + (unsigned)tok0) * 2u + vc1 * 16;
#define ATT_DMA(j, buf) do { LAS unsigned char* _b = lds + (buf) * ATT_BUF; const unsigned _j = (unsigned)(j); \
        __builtin_amdgcn_global_load_lds((const unsigned*)(KN + (size_t)(okn0 + _j * 262144u)), (LAS unsigned*)(_b + ATT_KN + wid * 2048), 16, 0, 0); \
        __builtin_amdgcn_global_load_lds((const unsigned*)(KN + (size_t)(okn1 + _j * 262144u)), (LAS unsigned*)(_b + ATT_KN + wid * 2048 + 1024), 16, 0, 0); \
        __builtin_amdgcn_global_load_lds((const unsigned*)(KRB + (size_t)(okr + _j * 8192u)), (LAS unsigned*)(_b + ATT_KR + wid * 1024), 16, 0, 0); \
        __builtin_amdgcn_global_load_lds((const unsigned*)(VT + (size_t)(ov0 + _j * 128u)), (LAS unsigned*)(_b + ATT_V + wid * 2048), 16, 0, 0); \
        __builtin_amdgcn_global_load_lds((const unsigned*)(VT + (size_t)(ov1 + _j * 128u)), (LAS unsigned*)(_b + ATT_V + wid * 2048 + 1024), 16, 0, 0); } while (0)
    ATT_DMA(0, 0);
    asm volatile("s_waitcnt vmcnt(0)" ::: "memory");
    __syncthreads();
    const int krow = (q & ~12) | ((q & 4) << 1) | ((q & 8) >> 1);
    const int kx = krow & 15, ksw = (krow >> 1) & 7, vsw = (q >> 1) & 7;
    const unsigned kn_b = ATT_KN + krow * 256 + ((g ^ kx) & 1) * 16, kn_t = (unsigned)(kx >> 1) << 5;
    const unsigned kr_b = ATT_KR + krow * 128 + ((g ^ ksw) & 1) * 16, kr_t = (unsigned)(ksw >> 1) << 5;
    const unsigned v_b = ATT_V + q * 128 + ((g ^ vsw) & 1) * 16, v_t = (unsigned)(vsw >> 1) << 5;
    const bool grpY = wid >= 4;
    bf16x8 pf[4];
#pragma unroll
    for (int s = 0; s < 4; ++s) pf[s] = (bf16x8){0, 0, 0, 0, 0, 0, 0, 0};
#define ATT_VF(d, s) (*(const LAS bf16x8*)(bb + v_b + (d) * 32 * 128 + (((unsigned)(s) << 5) ^ vtt)))
#define ATT_PV(bufidx) do { LAS unsigned char* bb = lds + (bufidx) * ATT_BUF; unsigned vtt = v_t; asm volatile("" : "+v"(vtt)); \
            bf16x8 va[4], vb[4]; \
            _Pragma("unroll") \
            for (int s = 0; s < 4; ++s) va[s] = ATT_VF(0, s); \
            _Pragma("unroll") \
            for (int s = 0; s < 4; ++s) vb[s] = ATT_VF(1, s); \
            __builtin_amdgcn_sched_barrier(0); \
            _Pragma("unroll") \
            for (int s = 0; s < 4; ++s) o[0] = MFMA32(va[s], pf[s], o[0]); \
            _Pragma("unroll") \
            for (int s = 0; s < 4; ++s) va[s] = ATT_VF(2, s); \
            __builtin_amdgcn_sched_barrier(0); \
            _Pragma("unroll") \
            for (int s = 0; s < 4; ++s) o[1] = MFMA32(vb[s], pf[s], o[1]); \
            _Pragma("unroll") \
            for (int s = 0; s < 4; ++s) vb[s] = ATT_VF(3, s); \
            __builtin_amdgcn_sched_barrier(0); \
            _Pragma("unroll") \
            for (int s = 0; s < 4; ++s) o[2] = MFMA32(va[s], pf[s], o[2]); \
            _Pragma("unroll") \
            for (int s = 0; s < 4; ++s) o[3] = MFMA32(vb[s], pf[s], o[3]); \
        } while (0)
    int bj = 0, bprev = 2;
    for (int j = 0; j < ntiles; ++j) {
        const int bnext = (bj == 2) ? 0 : bj + 1;
        if (j + 1 < ntiles) ATT_DMA(j + 1, bnext);
        if (grpY && j >= 1 && j - 1 <= my_last) ATT_PV(bprev);
        if (j <= my_last) {
            LAS unsigned char* bb = lds + bj * ATT_BUF;
            f32x16 sa[2];
#pragma unroll
            for (int mb = 0; mb < 2; ++mb)
#pragma unroll
                for (int i = 0; i < 16; ++i) sa[mb][i] = 0.f;
            unsigned knt = kn_t, krt = kr_t; asm volatile("" : "+v"(knt), "+v"(krt));
#define ATT_KF(mb, s) (*(const LAS bf16x8*)(bb + ((s) < 8 ? kn_b + (mb) * 32 * 256 + (((unsigned)(s) << 5) ^ knt) : kr_b + (mb) * 32 * 128 + (((unsigned)((s) - 8) << 5) ^ krt))))
            bf16x8 ka[3], kb[3];
#define ATT_LDG(dst, i) do { _Pragma("unroll") for (int s_ = 0; s_ < 3; ++s_) dst[s_] = ATT_KF((i) >> 2, 3 * ((i) & 3) + s_); } while (0)
#define ATT_MMG(src, i) do { _Pragma("unroll") for (int s_ = 0; s_ < 3; ++s_) sa[(i) >> 2] = MFMA32(src[s_], qf[3 * ((i) & 3) + s_], sa[(i) >> 2]); } while (0)
            ATT_LDG(ka, 0); ATT_LDG(kb, 1); __builtin_amdgcn_sched_barrier(0);
            ATT_MMG(ka, 0); ATT_LDG(ka, 2); __builtin_amdgcn_sched_barrier(0);
            ATT_MMG(kb, 1); ATT_LDG(kb, 3); __builtin_amdgcn_sched_barrier(0);
            ATT_MMG(ka, 2); ATT_LDG(ka, 4); __builtin_amdgcn_sched_barrier(0);
            ATT_MMG(kb, 3); ATT_LDG(kb, 5); __builtin_amdgcn_sched_barrier(0);
            ATT_MMG(ka, 4); ATT_LDG(ka, 6); __builtin_amdgcn_sched_barrier(0);
            ATT_MMG(kb, 5); ATT_LDG(kb, 7); __builtin_amdgcn_sched_barrier(0);
            ATT_MMG(ka, 6); ATT_MMG(kb, 7); __builtin_amdgcn_sched_barrier(0);
#undef ATT_LDG
#undef ATT_MMG
#undef ATT_KF
            float mx = sa[0][0];
#pragma unroll
            for (int i = 0; i < 16; ++i) { mx = fmaxf(mx, sa[0][i]); mx = fmaxf(mx, sa[1][i]); }
            mx = fmaxf(mx, __shfl_xor(mx, 32));
            const float mnew = fmaxf(mrun, mx), alpha = __builtin_amdgcn_exp2f(mrun - mnew);
            float ps = 0.f;
#pragma unroll
            for (int mb = 0; mb < 2; ++mb)
#pragma unroll
                for (int i = 0; i < 16; ++i) { const float e = __builtin_amdgcn_exp2f(sa[mb][i] - mnew); sa[mb][i] = e; ps += e; }
            lrun = lrun * alpha + ps; mrun = mnew;
#pragma unroll
            for (int d = 0; d < 4; ++d)
#pragma unroll
                for (int i = 0; i < 16; ++i) o[d][i] *= alpha;
#pragma unroll
            for (int s = 0; s < 4; ++s) { const int mb = s >> 1, o8 = (s & 1) * 8; u32x4 w;
                w.x = cvt_pk_bf16(sa[mb][o8 + 0], sa[mb][o8 + 1]); w.y = cvt_pk_bf16(sa[mb][o8 + 2], sa[mb][o8 + 3]); w.z = cvt_pk_bf16(sa[mb][o8 + 4], sa[mb][o8 + 5]); w.w = cvt_pk_bf16(sa[mb][o8 + 6], sa[mb][o8 + 7]);
                pf[s] = __builtin_bit_cast(bf16x8, w); }
        }
        if (!grpY && j <= my_last) ATT_PV(bj);
        asm volatile("s_waitcnt vmcnt(0)" ::: "memory");
        __syncthreads();
        bprev = bj; bj = bnext;
    }
    if (grpY && ntiles - 1 <= my_last) ATT_PV(bprev);
#undef ATT_PV
#undef ATT_VF
    const float lt = lrun + __shfl_xor(lrun, 32), il = 1.0f / lt;
    bf16_t* op = (bf16_t*)(ws + OFF_O) + (size_t)qrow * 2048 + h * 128 + 4 * g;
#pragma unroll
    for (int d = 0; d < 4; ++d)
#pragma unroll
        for (int i = 0; i < 4; ++i) { u32x2 w; w.x = cvt_pk_bf16(o[d][4 * i] * il, o[d][4 * i + 1] * il); w.y = cvt_pk_bf16(o[d][4 * i + 2] * il, o[d][4 * i + 3] * il);
            *(u32x2*)(op + 32 * d + 8 * i) = w; }
#undef ATT_DMA
}

DI void phase_softmax(unsigned char* ws, const int wv) {
    const _Float16* S = (const _Float16*)(ws + OFF_S); bf16_t* P = (bf16_t*)(ws + OFF_P);
    const int lane = lane_id(), gw = blockIdx.x * 8 + wv, nw = gridDim.x * 8;
    for (int r = gw; r < 16384; r += nw) {
        const _Float16* sp = S + (size_t)r * 1056;
        f32x4 v[5]; float mx = -1e30f;
#pragma unroll
        for (int k = 0; k < 5; ++k) { const int ci = lane + 64 * k; if (ci < 264) { v[k] = __builtin_convertvector(*(const f16x4*)(sp + ci * 4), f32x4); mx = fmaxf(mx, fmaxf(fmaxf(v[k][0], v[k][1]), fmaxf(v[k][2], v[k][3]))); } else v[k] = (f32x4){-1e30f, -1e30f, -1e30f, -1e30f}; }
        mx = wave_max(mx);
        float sum = 0.f;
#pragma unroll
        for (int k = 0; k < 5; ++k) { const int ci = lane + 64 * k;
#pragma unroll
            for (int e = 0; e < 4; ++e) { const float x = (ci < 264) ? __builtin_amdgcn_exp2f(v[k][e] - mx) : 0.f; v[k][e] = x; sum += x; } }
        sum = wave_sum(sum); const float is = 1.0f / sum;
#pragma unroll
        for (int k = 0; k < 5; ++k) { const int ci = lane + 64 * k; if (ci < 288) { u32x2 w; w.x = cvt_pk_bf16(v[k][0] * is, v[k][1] * is); w.y = cvt_pk_bf16(v[k][2] * is, v[k][3] * is);
            *(u32x2*)(P + (size_t)r * 1152 + ci * 4) = w; } }
    }
}


#define XB_TMO      128
#define XB_XCNT(j)  (256  + 64 * (j))
#define XB_XSUB(j)  (1280 + 64 * (j))
#define XB_XGEN(j)  (2304 + 64 * (j))
#define XB_TOP      3328
#define XB_TOPGEN   3392
#define XCD_BAR_WORDS 3456
#define XB_SPIN_CAP (1u << 22)
DI unsigned xb_ld(unsigned* p)              { return __hip_atomic_load(p, __ATOMIC_RELAXED, __HIP_MEMORY_SCOPE_AGENT); }
DI unsigned xb_add(unsigned* p, unsigned v) { return __hip_atomic_fetch_add(p, v, __ATOMIC_RELAXED, __HIP_MEMORY_SCOPE_AGENT); }
DI unsigned xb_xcc_id() { return (unsigned)__builtin_amdgcn_s_getreg((3 << 11) | 20) & 0xFu; }
#define XB_SPIN(cond, bar) do { unsigned _sp = 0; while (cond) { __builtin_amdgcn_s_sleep(1); \
    if ((++_sp & 255u) == 0u) { if (xb_ld(&(bar)[XB_TMO])) break; if (_sp > XB_SPIN_CAP) { atomicAdd(&(bar)[XB_TMO], 1u); break; } } } } while (0)
struct XcdBarrier { unsigned* bar; unsigned x; volatile LAS unsigned* st; };
DI XcdBarrier xcd_barrier_post(unsigned* bar, volatile LAS unsigned* st, bool leader) {
    XcdBarrier b; b.bar = bar; b.x = xb_xcc_id(); b.st = st;
    if (leader) (void)xb_add(&bar[XB_XCNT(b.x)], 1u);
    return b;
}
DI void xcd_barrier_complete(unsigned* bar, unsigned x, unsigned& nloc, unsigned& nx) {
    const unsigned G = gridDim.x * gridDim.y * gridDim.z;
    unsigned sum, cnt, mine, sp = 0u;
    for (;;) {
        sum = 0u; cnt = 0u; mine = 0u;
#pragma unroll
        for (unsigned j = 0; j < 16; ++j) { const unsigned c = xb_ld(&bar[XB_XCNT(j)]); sum += c; cnt += (c > 0u) ? 1u : 0u; mine = (j == x) ? c : mine; }
        if (sum == G) break;
        __builtin_amdgcn_s_sleep(1);
        if ((++sp & 255u) == 0u) { if (xb_ld(&bar[XB_TMO])) break; if (sp > XB_SPIN_CAP) { atomicAdd(&bar[XB_TMO], 1u); break; } }
    }
    nloc = mine > 0u ? mine : 1u; nx = cnt > 0u ? cnt : 1u;
}
DI void xcd_barrier(const XcdBarrier& b, bool leader) {
    asm volatile("s_waitcnt vmcnt(0)" ::: "memory");
    __syncthreads();
    if (leader) {
        unsigned* bar = b.bar;
        __builtin_amdgcn_s_waitcnt(0);
        unsigned nloc = b.st[0], nx = b.st[1];
        if (nloc == 0u) { xcd_barrier_complete(bar, b.x, nloc, nx); b.st[0] = nloc; b.st[1] = nx; }
        const unsigned old = xb_add(&bar[XB_XSUB(b.x)], 1u);
        const unsigned gen = old / nloc;
        if (old + 1u == (gen + 1u) * nloc) {
            __builtin_amdgcn_fence(__ATOMIC_RELEASE, "agent");
            asm volatile("s_waitcnt vmcnt(0)" ::: "memory");
            const unsigned og = xb_add(&bar[XB_TOP], 1u);
            const unsigned tg = og / nx;
            if (og + 1u == (tg + 1u) * nx) xb_add(&bar[XB_TOPGEN], 1u);
            else XB_SPIN(xb_ld(&bar[XB_TOPGEN]) == tg, bar);
            __builtin_amdgcn_fence(__ATOMIC_ACQUIRE, "agent");
            xb_add(&bar[XB_XGEN(b.x)], 1u);
            asm volatile("s_waitcnt vmcnt(0)" ::: "memory");
        } else {
            XB_SPIN(xb_ld(&bar[XB_XGEN(b.x)]) == gen, bar);
            __builtin_amdgcn_fence(__ATOMIC_ACQUIRE, "agent");
            asm volatile("s_waitcnt vmcnt(0)" ::: "memory");
        }
    }
    __syncthreads();
}

#ifndef REPEAT_MASK
#define REPEAT_MASK 0
#endif
#define PH_REP(n) ((((REPEAT_MASK) >> (n)) & 1) ? 2 : 1)
#define PHASE_BEGIN(n) if (PH_ON((n) == 15 ? 1 : (n) == 16 ? 2 : (n)) && p.ph_lo <= (n) && (n) < p.ph_hi) { for (int rep_ = 0; rep_ < PH_REP(n); ++rep_) { unsigned long long wsi_ = (unsigned long long)p.ws, hi_ = (unsigned long long)p.out; asm volatile("" : "+s"(wsi_), "+s"(hi_)); unsigned char* ws = (unsigned char*)(GAS unsigned char*)wsi_; float* H = (float*)(GAS float*)hi_;
#define PHASE_END(n) } } if (p.ph_lo <= (n) && (n) + 1 < p.ph_hi) { xcd_barrier(xbar, xlead); }
__global__ void __launch_bounds__(512, 2) fwd_kernel(Params p) {
    extern __shared__ __attribute__((aligned(16))) unsigned char shm[];
    LAS unsigned char* lds = (LAS unsigned char*)shm;
    float* smf = (float*)shm;
    const int wv = __builtin_amdgcn_readfirstlane((int)(threadIdx.x >> 6));
    const bool xlead = (wv == 0) && (lane_id() == 0);
    volatile LAS unsigned* xst = (volatile LAS unsigned*)(lds + pg8::STAGE_BYTES);
    XcdBarrier xbar; xbar.bar = nullptr; xbar.x = 0; xbar.st = xst;
    if (p.ph_hi - p.ph_lo > 1) {
        if (xlead) { xst[0] = 0u; xst[1] = 0u; }
        __syncthreads();
        xbar = xcd_barrier_post((unsigned*)(p.ws + WS_BAR), xst, xlead);
    }
    if (p.ph_lo > p.ph_hi) cg::this_grid().sync();
    using namespace pg8;
    PHASE_BEGIN(0) {
            convert_ffn_weights(p, ws, 0, smf, blockIdx.x, gridDim.x, wv, 1);
            rmsnorm_rows_bf16(p.in[0], p.in[1], p.in[5], (bf16_t*)(ws + OFF_XN), nullptr, nullptr, wv);
    } PHASE_END(0)
#define FFN_UP_BODY(spl) {     \
            Gemm g{}; g.A = (const char*)(ws + OFF_XN); g.B = (const char*)(ws + OFF_WGU); g.lda = 2048; g.ldb = 2048; g.K = 2048; g.nM = 36; g.nN = 44; g.nB = 1; g.split = spl; \
            g.a_ts = 256ll * 2048 * 2; g.b_ts = 256ll * 2048 * 2; \
            EpiSwiglu E{(bf16_t*)(ws + OFF_G), (float*)(ws + OFF_SLABG)}; \
            gemm_phase(lds, g, E, wv); }
    PHASE_BEGIN(1) FFN_UP_BODY(0)
        { const int extra = (36 * 44) % (int)gridDim.x, nconv = (int)gridDim.x - extra;
          if (extra == 0) { convert_ffn_weights(p, ws, 0, smf, blockIdx.x, gridDim.x, wv, 2); convert_other_weights(p, ws, smf, blockIdx.x, gridDim.x, wv); }
          else if ((int)blockIdx.x >= extra) { convert_ffn_weights(p, ws, 0, smf, blockIdx.x - extra, nconv, wv, 2); convert_other_weights(p, ws, smf, blockIdx.x - extra, nconv, wv); } }
    PHASE_END(1)
#define FFN_DOWN_BODY(ph) {     \
            Gemm g{}; g.A = (const char*)(ws + OFF_G); g.B = (const char*)(ws + OFF_WD); g.lda = DFF; g.ldb = DFF; g.K = DFF; g.nM = 36; g.nN = 8; g.nB = 1; g.split = 1; \
            g.a_ts = 256ll * DFF * 2; g.b_ts = 256ll * DFF * 2; \
            EpiResid E{H, ph == 2 ? p.in[0] : H, ph == 2 ? p.in[1] : H + (size_t)NPT * DM, 0.5f, (float*)(ws + OFF_SLAB), nullptr, ph == 2 ? (bf16_t*)(ws + OFF_HB) : nullptr}; \
            gemm_phase(lds, g, E, wv); }
    PHASE_BEGIN(2) FFN_DOWN_BODY(2) PHASE_END(2)
    PHASE_BEGIN(3) rmsnorm_rows_bf16(H, p.in[1], p.in[9], (bf16_t*)(ws + OFF_XN), (const float*)(ws + OFF_SLAB), H + (size_t)NPT * DM, wv, (const bf16_t*)(ws + OFF_HB)); PHASE_END(3)
    PHASE_BEGIN(4) {
            Gemm g{}; g.A = (const char*)(ws + OFF_XN); g.B = (const char*)(ws + OFF_WIN); g.lda = 2048; g.ldb = 2048; g.K = 2048; g.nM = 36; g.nN = 25; g.nB = 1;
            g.a_ts = 256ll * 2048 * 2; g.b_ts = 256ll * 2048 * 2;
            EpiWin E{(float*)(ws + OFF_Z), (float*)(ws + OFF_QLR), (float*)(ws + OFF_CKR), (bf16_t*)(ws + OFF_GATES), (bf16_t*)(ws + OFF_KRB), p.out + OUT_KR_P, p.out + OUT_KR_S, p.out + OUT_POOL_P, p.out + OUT_POOL_S};
            gemm_phase(lds, g, E, wv);
            { const int extra = (36 * 25) % (int)gridDim.x, nconv = (int)gridDim.x - extra;
              if (extra == 0) convert_cache(p, ws, smf, blockIdx.x, gridDim.x, wv); else if ((int)blockIdx.x >= extra) convert_cache(p, ws, smf, blockIdx.x - extra, nconv, wv); }
    } PHASE_END(4)
    PHASE_BEGIN(5) phase_token_local(p, ws, smf, wv);
        {
            const float* s = p.in[14]; bf16_t* d = (bf16_t*)(ws + OFF_WUKP);
            for (int i = blockIdx.x * 512 + TIDX; i < 512 * 2048 / 8; i += gridDim.x * 512) { const f32x4 a = *(const f32x4*)(s + (size_t)i * 8), c = *(const f32x4*)(s + (size_t)i * 8 + 4);
                u32x4 w; w.x = cvt_pk_bf16(a[0], a[1]); w.y = cvt_pk_bf16(a[2], a[3]); w.z = cvt_pk_bf16(c[0], c[1]); w.w = cvt_pk_bf16(c[2], c[3]); *(u32x4*)(d + (size_t)i * 8) = w; }
        }
    PHASE_END(5)
    PHASE_BEGIN(6) {
            {
                Gemm g{}; g.A = (const char*)(ws + OFF_QLAT); g.B = (const char*)(ws + OFF_WUQ); g.lda = 512; g.ldb = 512; g.K = 512; g.nM = 36; g.nN = 12; g.nB = 1;
                g.a_ts = 256ll * 512 * 2; g.b_ts = 256ll * 512 * 2;
                EpiQ E{(bf16_t*)(ws + OFF_QN), (bf16_t*)(ws + OFF_QR), (bf16_t*)(ws + OFF_QABS)};
                gemm_phase(lds, g, E, wv);
            }
            {
                Gemm g{}; g.A = (const char*)(ws + OFF_CKVP); g.B = (const char*)(ws + OFF_WUKT); g.lda = 512; g.ldb = 512; g.K = 512; g.nM = 32; g.nN = 8; g.nB = 1;
                g.a_ts = 256ll * 512 * 2; g.b_ts = 256ll * 512 * 2; g.rot = 176;
                EpiBf16 E{(bf16_t*)(ws + OFF_KN), 2048, 0, 1.0f, 0};
                gemm_phase(lds, g, E, wv);
            }
            {
                Gemm g{}; g.A = (const char*)(ws + OFF_WUVT); g.B = (const char*)(ws + OFF_CKVP); g.lda = 512; g.ldb = 512; g.K = 512; g.nM = 8; g.nN = 32; g.nB = 1;
                g.a_ts = 256ll * 512 * 2; g.b_ts = 256ll * 512 * 2; g.rot = 176;
                EpiBf16 E{(bf16_t*)(ws + OFF_VT), 8192, 0, 1.0f, 0};
                gemm_phase(lds, g, E, wv);
            }
            {
                Gemm g{}; g.A = (const char*)(ws + OFF_POOLED); g.B = (const char*)(ws + OFF_WPOOL); g.lda = 1024; g.ldb = 256; g.K = 256; g.nM = 36; g.nN = 1; g.nB = 4;
                g.a_ts = 256ll * 1024 * 2; g.b_ts = 0; g.a_bs = 512; g.b_bs = 65536ll * 2; g.rot = 176;
                EpiPoolMix E{(bf16_t*)(ws + OFF_MIXED), p.in[18]};
                gemm_phase(lds, g, E, wv);
            }
    } PHASE_END(6)
    PHASE_BEGIN(7) {
            {
                Gemm g{}; g.A = (const char*)(ws + OFF_QN) + (size_t)NPT * 2048 * 2; g.B = (const char*)(ws + OFF_WUKP); g.lda = 2048; g.ldb = 2048; g.K = 128; g.nM = 4; g.nN = 2; g.nB = 16;
                g.a_ts = 256ll * 2048 * 2; g.b_ts = 256ll * 2048 * 2; g.a_bs = 256; g.b_bs = 256; g.rot = 32;
                EpiBf16 E{(bf16_t*)(ws + OFF_QABS), 16 * 640, 640, 1.0f, 0};
                gemm_phase(lds, g, E, wv);
            }
            {
                const int c = blockIdx.x;
                for (int pr = c; pr < 256; pr += gridDim.x) {
                    const int bh = (pr & 7) * 8 + ((pr >> 3) >> 2), i = (pr >> 3) & 3;
                    attn_item(ws, lds, bh >> 4, bh & 15, 7 - i, wv);
                    attn_item(ws, lds, bh >> 4, bh & 15, i, wv);
                }
            }
    } PHASE_END(7)
    PHASE_BEGIN(8) {
            Gemm g{}; g.A = (const char*)(ws + OFF_QABS); g.B = (const char*)(ws + OFF_KALL); g.lda = 640; g.ldb = 640; g.K = 640; g.nM = 2; g.nN = 5; g.nB = 32;
            g.a_ts = 256ll * 640 * 2; g.b_ts = 256ll * 640 * 2; g.a_bs = 512ll * 640 * 2; g.b_bs = 1056ll * 640 * 2;
            EpiScore E{(_Float16*)(ws + OFF_S)};
            gemm_phase(lds, g, E, wv);
    } PHASE_END(8)
    PHASE_BEGIN(9) phase_softmax(ws, wv); PHASE_END(9)
    PHASE_BEGIN(10) {
            Gemm g{}; g.A = (const char*)(ws + OFF_P); g.B = (const char*)(ws + OFF_CKVT); g.lda = 1152; g.ldb = 1152; g.K = 1152; g.nM = 2; g.nN = 2; g.nB = 32;
            g.a_ts = 256ll * 1152 * 2; g.b_ts = 256ll * 1152 * 2; g.a_bs = 512ll * 1152 * 2; g.b_bs = 512ll * 1152 * 2;
            EpiBf16 E{(bf16_t*)(ws + OFF_OLAT), 512, 512ll * 512, 1.0f, 0};
            gemm_phase(lds, g, E, wv);
            {
                Gemm g2{}; g2.A = (const char*)(ws + OFF_MIXED); g2.B = (const char*)(ws + OFF_WPO); g2.lda = 1024; g2.ldb = 1024; g2.K = 1024; g2.nM = 36; g2.nN = 8; g2.nB = 1;
                g2.a_ts = 256ll * 1024 * 2; g2.b_ts = 256ll * 1024 * 2; g2.u0 = 0; g2.u1 = 128; g2.boff = 128; g2.nblk = (int)gridDim.x - 128;
                EpiGate E2{(bf16_t*)(ws + OFF_GA), (const bf16_t*)(ws + OFF_GATES), nullptr, 0, 0};
                gemm_phase(lds, g2, E2, wv);
            }
    } PHASE_END(10)
    PHASE_BEGIN(11) {
            {
            Gemm g{}; g.A = (const char*)(ws + OFF_OLAT); g.B = (const char*)(ws + OFF_WUVT); g.lda = 8192; g.ldb = 512; g.K = 512; g.nM = 4; g.nN = 1; g.nB = 16;
            g.a_ts = 256ll * 8192 * 2; g.b_ts = 0; g.a_bs = 512 * 2; g.b_bs = 128ll * 512 * 2;
            EpiBf16 E{(bf16_t*)(ws + OFF_O) + (size_t)NPT * 2048, 2048, 128, 1.0f, 1};
            gemm_phase(lds, g, E, wv);
            }
            {
                Gemm g{}; g.A = (const char*)(ws + OFF_MIXED); g.B = (const char*)(ws + OFF_WPO); g.lda = 1024; g.ldb = 1024; g.K = 1024; g.nM = 36; g.nN = 8; g.nB = 1;
                g.a_ts = 256ll * 1024 * 2; g.b_ts = 256ll * 1024 * 2; g.u0 = 128; g.u1 = 288; g.boff = 64; g.nblk = (int)gridDim.x - 64;
                EpiGate E{(bf16_t*)(ws + OFF_GA), (const bf16_t*)(ws + OFF_GATES), nullptr, 0, 0};
                gemm_phase(lds, g, E, wv);
            }
    } PHASE_END(11)
    PHASE_BEGIN(12) {
            Gemm g{}; g.A = (const char*)(ws + OFF_O); g.B = (const char*)(ws + OFF_WOA); g.lda = 2048; g.ldb = 2048; g.K = 2048; g.nM = 36; g.nN = 8; g.nB = 1;
            g.a_ts = 256ll * 2048 * 2; g.b_ts = 256ll * 2048 * 2;
            EpiGate E{(bf16_t*)(ws + OFF_MERGED), (const bf16_t*)(ws + OFF_GATES), (const bf16_t*)(ws + OFF_GA), 2048, 1};
            gemm_phase(lds, g, E, wv);
            { const int extra = (36 * 8) % (int)gridDim.x, nconv = (int)gridDim.x - extra;
              if (extra == 0) convert_ffn_weights(p, ws, 1, smf, blockIdx.x, gridDim.x, wv); else if ((int)blockIdx.x >= extra) convert_ffn_weights(p, ws, 1, smf, blockIdx.x - extra, nconv, wv); }
    } PHASE_END(12)
    PHASE_BEGIN(13) {
            Gemm g{}; g.A = (const char*)(ws + OFF_MERGED); g.B = (const char*)(ws + OFF_WOUT); g.lda = 2048; g.ldb = 2048; g.K = 2048; g.nM = 36; g.nN = 8; g.nB = 1; g.split = 1;
            g.a_ts = 256ll * 2048 * 2; g.b_ts = 256ll * 2048 * 2;
            EpiResid E{H, H, H + (size_t)NPT * DM, 1.0f, (float*)(ws + OFF_SLAB), (const bf16_t*)(ws + OFF_HB), nullptr};
            gemm_phase(lds, g, E, wv);
    } PHASE_END(13)
    PHASE_BEGIN(14) {
            rmsnorm_rows_bf16(H, H + (size_t)NPT * DM, p.in[21], (bf16_t*)(ws + OFF_XN), (const float*)(ws + OFF_SLAB), H + (size_t)NPT * DM, wv);
    } PHASE_END(14)
    PHASE_BEGIN(15) FFN_UP_BODY((p.ph_hi - p.ph_lo > 1) ? 2 : 0) PHASE_END(15)
    if (PH_ON(1) && p.ph_lo <= 15 && 16 < p.ph_hi) {
        unsigned long long wsi_ = (unsigned long long)p.ws; asm volatile("" : "+s"(wsi_)); unsigned char* ws = (unsigned char*)(GAS unsigned char*)wsi_;
        const int G_ = gridDim.x, nwg = 36 * 44, full = (nwg / G_) * G_, left = nwg - full, tid = TIDX;
        const int lane = tid & 63, wid = tid >> 6, wr = wid >> 2, wc = wid & 3, fr = lane & 15, fq = lane >> 4;
        const float* slab = (const float*)(ws + OFF_SLABG); bf16_t* Gout = (bf16_t*)(ws + OFF_G);
        for (int it = blockIdx.x; it < left * 16; it += G_) {
            const int lu = it >> 4, ai = (it >> 3) & 1, m = (it >> 1) & 3, n = it & 1; int pm, pn; pg8::map_unit(full + lu, 36, 44, nwg, pm, pn);
            f32x4 gs = (f32x4){0.f, 0.f, 0.f, 0.f}, us = gs;
#pragma unroll
            for (int kp = 0; kp < 4; ++kp) { const bf16_t* sp = (const bf16_t*)slab + ((size_t)(lu * 4 + kp) * 32 * 512 + tid) * 4;
                const u32x2 wg = *(const u32x2*)(sp + (size_t)(((ai * 2 + 0) * 4 + m) * 2 + n) * 2048), wu = *(const u32x2*)(sp + (size_t)(((ai * 2 + 1) * 4 + m) * 2 + n) * 2048);
                gs += (f32x4){bflo(wg.x), bfhi(wg.x), bflo(wg.y), bfhi(wg.y)}; us += (f32x4){bflo(wu.x), bfhi(wu.x), bflo(wu.y), bfhi(wu.y)}; }
            u32x2 w; w.x = cvt_pk_bf16(silu_f(gs[0]) * us[0], silu_f(gs[1]) * us[1]); w.y = cvt_pk_bf16(silu_f(gs[2]) * us[2], silu_f(gs[3]) * us[3]);
            *(u32x2*)(Gout + (size_t)(pm * 256 + ai * 128 + wr * 64 + m * 16 + fr) * DFF + pn * 128 + wc * 32 + 8 * fq + 4 * n) = w;
        }
        xcd_barrier(xbar, xlead);
    }
    PHASE_BEGIN(16) FFN_DOWN_BODY(16) PHASE_END(16)
    PHASE_BEGIN(17) {
            const int lane = lane_id(), gw = blockIdx.x * 8 + wv, nw = gridDim.x * 8; const float* gain = p.in[25];
            for (int r = gw; r < NTOK; r += nw) {
                float* sp = H + (size_t)r * DM; f32x4 v[8]; float ss = 0.f;
#pragma unroll
                for (int i = 0; i < 8; ++i) v[i] = *(const f32x4*)(sp + i * 256 + lane * 4);
                if (r >= NPT) {
#pragma unroll
                    for (int sidx = 0; sidx < 8; ++sidx) { const bf16_t* sl = (const bf16_t*)(ws + OFF_SLAB) + ((size_t)sidx * NST + (r - NPT)) * DM;
#pragma unroll
                        for (int i = 0; i < 8; ++i) { const u32x2 w = *(const u32x2*)(sl + i * 256 + lane * 4); v[i] += (f32x4){bflo(w.x), bfhi(w.x), bflo(w.y), bfhi(w.y)}; } }
                }
#pragma unroll
                for (int i = 0; i < 8; ++i) ss += v[i][0] * v[i][0] + v[i][1] * v[i][1] + v[i][2] * v[i][2] + v[i][3] * v[i][3];
                ss = wave_sum(ss); const float rstd = rsqrtf(ss * (1.0f / 2048.0f) + 1e-6f);
#pragma unroll
                for (int i = 0; i < 8; ++i) { const f32x4 g = *(const f32x4*)(gain + i * 256 + lane * 4); *(f32x4*)(sp + i * 256 + lane * 4) = v[i] * rstd * g; }
            }
    } PHASE_END(17)
}


extern "C" void kernel_launch(void* const* d_in, const int* in_sizes, int n_in, void* d_out, int out_size, void* d_ws, size_t ws_size, hipStream_t stream) {
    constexpr int LDS_BYTES = pg8::STAGE_BYTES + 16;
    static int grid = 0;
    if (grid == 0) {
        if (n_in != 26 || ws_size < WS_END || out_size != 24735744) { fprintf(stderr, "kernel_launch: unexpected problem (n_in %d, ws %zu need %zu, out %d)\n", n_in, ws_size, (size_t)WS_END, out_size); grid = -1; return; }
        int dev = 0, cus = 0, per_cu = 0;
        hipGetDevice(&dev); hipDeviceGetAttribute(&cus, hipDeviceAttributeMultiprocessorCount, dev);
        if (hipFuncSetAttribute((const void*)fwd_kernel, hipFuncAttributeMaxDynamicSharedMemorySize, LDS_BYTES) != hipSuccess) { fprintf(stderr, "kernel_launch: hipFuncSetAttribute failed\n"); grid = -1; return; }
        if (hipOccupancyMaxActiveBlocksPerMultiprocessor(&per_cu, (const void*)fwd_kernel, 512, LDS_BYTES) != hipSuccess || per_cu < 1) { fprintf(stderr, "kernel_launch: occupancy query failed (%d)\n", per_cu); (void)hipGetLastError(); per_cu = 1; }
        grid = cus * 1;
        (void)per_cu;
    }
    if (grid < 0) return;
    Params p{};
    for (int i = 0; i < 26; ++i) p.in[i] = (const float*)d_in[i];
    p.out = (float*)d_out; p.ws = (unsigned char*)d_ws;
#if SINGLE_LAUNCH
    p.ph_lo = 0; p.ph_hi = NPHASE;
    if (hipMemsetAsync((unsigned char*)d_ws + WS_BAR, 0, 16384, stream) != hipSuccess) { fprintf(stderr, "kernel_launch: memset of the barrier words failed\n"); return; }
    void* args[] = {&p};
    hipError_t e = hipLaunchCooperativeKernel((const void*)fwd_kernel, dim3(grid), dim3(512), args, LDS_BYTES, stream);
    if (e != hipSuccess) fprintf(stderr, "cooperative launch failed: %s (grid %d)\n", hipGetErrorString(e), grid);
#else
    for (int ph = 0; ph < NPHASE; ++ph) {
        p.ph_lo = ph; p.ph_hi = ph + 1;
        hipLaunchKernelGGL(fwd_kernel, dim3(grid), dim3(512), LDS_BYTES, stream, p);
    }
#endif
}
```

```cpp
#include <hip/hip_runtime.h>
#include <hip/hip_cooperative_groups.h>
#include <cstdio>
namespace cg = cooperative_groups;

#ifndef PHASE_MASK
#define PHASE_MASK 0x3ffff
#endif
#define PH_ON(n) (((PHASE_MASK) >> (n)) & 1)
#ifndef SINGLE_LAUNCH
#define SINGLE_LAUNCH 1
#endif

#define LAS __attribute__((address_space(3)))
#define GAS __attribute__((address_space(1)))
#define DI __device__ __forceinline__
typedef unsigned short bf16_t;
typedef short bf16x8 __attribute__((ext_vector_type(8)));
typedef float f32x4 __attribute__((ext_vector_type(4)));
typedef float f32x16 __attribute__((ext_vector_type(16)));
typedef unsigned u32x4 __attribute__((ext_vector_type(4)));
typedef unsigned u32x2 __attribute__((ext_vector_type(2)));
typedef _Float16 f16x4 __attribute__((ext_vector_type(4)));

constexpr int NTOK = 9216, NPT = 8192, NST = 1024, DM = 2048, DFF = 5632;
constexpr int NPHASE = 18;
constexpr float QSCALE = 0.07216878364870322f * 1.4426950408889634f;

constexpr size_t SZ_WGU = (size_t)11264 * 2048 * 2, SZ_WD = (size_t)2048 * 5632 * 2;
constexpr size_t OFF_WFF = 0;
constexpr size_t OFF_WGU = OFF_WFF, OFF_WD = OFF_WFF + SZ_WGU;
constexpr size_t SZ_WFF = SZ_WGU + SZ_WD;
constexpr size_t OFF_WIN = OFF_WFF + SZ_WFF;
constexpr size_t OFF_WUQ = OFF_WIN + (size_t)6400 * 2048 * 2;
constexpr size_t OFF_WUKT = OFF_WUQ + (size_t)3072 * 512 * 2;
constexpr size_t OFF_WUVT = OFF_WUKT + (size_t)2048 * 512 * 2;
constexpr size_t OFF_WOA = OFF_WUVT + (size_t)2176 * 512 * 2;
constexpr size_t OFF_WPOOL = OFF_WOA + (size_t)2048 * 2048 * 2;
constexpr size_t OFF_WPO = OFF_WPOOL + (size_t)4 * 256 * 256 * 2;
constexpr size_t OFF_WOUT = OFF_WPO + (size_t)2048 * 1024 * 2;
constexpr size_t OFF_XN = OFF_WOUT + (size_t)2048 * 2048 * 2;
constexpr size_t SZ_XN = (size_t)NTOK * 2048 * 2;
constexpr size_t OFF_G = OFF_XN + SZ_XN;
constexpr size_t SZ_G = (size_t)NTOK * DFF * 2;
constexpr size_t OFF_GATES = OFF_G + SZ_G;
constexpr size_t OFF_QN = OFF_GATES + (size_t)NTOK * 4096 * 2;
constexpr size_t OFF_O = OFF_QN + (size_t)NTOK * 2048 * 2;
constexpr size_t OFF_KALL = OFF_O + (size_t)NTOK * 2048 * 2;
constexpr size_t OFF_CKVT = OFF_KALL + (size_t)(32 * 1056 + 224) * 640 * 2;
constexpr size_t OFF_KRB = OFF_CKVT + (size_t)32 * 512 * 1152 * 2;
constexpr size_t OFF_HB = OFF_KRB + (size_t)NTOK * 64 * 2;
constexpr size_t WS_BAR = OFF_HB + (size_t)NTOK * 2048 * 2;
constexpr size_t WS_END = WS_BAR + 16384;
constexpr size_t OFF_Z = OFF_G;
constexpr size_t OFF_QLR = OFF_Z + (size_t)NTOK * 1024 * 4;
constexpr size_t OFF_CKR = OFF_QLR + (size_t)NTOK * 512 * 4;
constexpr size_t OFF_KN = OFF_G;
constexpr size_t OFF_VT = OFF_KN + (size_t)NPT * 2048 * 2;
constexpr size_t OFF_QR = OFF_VT + (size_t)2048 * NPT * 2;
constexpr size_t OFF_S = OFF_G;
constexpr size_t OFF_QLAT = OFF_WFF;
constexpr size_t OFF_CKVP = OFF_QLAT + (size_t)NTOK * 512 * 2;
constexpr size_t OFF_GA = OFF_G;
constexpr size_t OFF_OLAT = OFF_WD;
constexpr size_t OFF_POOLED = OFF_XN;
constexpr size_t OFF_MIXED = OFF_POOLED + (size_t)NTOK * 1024 * 2;
constexpr size_t OFF_P = OFF_WGU;
constexpr size_t OFF_MERGED = OFF_XN;
constexpr size_t OFF_QABS = OFF_WIN;
constexpr size_t OFF_WUKP = OFF_G + (size_t)84 * 1048576;
static_assert(OFF_WUKP >= OFF_QR + (size_t)NPT * 1024 * 2 && OFF_WUKP + (size_t)512 * 2048 * 2 <= OFF_G + SZ_G, "WUKP placement");
constexpr size_t OFF_SLABG = OFF_GATES;
constexpr size_t OFF_SLAB = OFF_GATES;
static_assert((size_t)8 * NST * DM * 4 <= (size_t)NTOK * 4096 * 2, "SLAB overflow");
static_assert(OFF_QR + (size_t)NPT * 1024 * 2 <= OFF_G + SZ_G, "G region overflow");
static_assert((size_t)16384 * 1056 * 4 <= SZ_G, "S overflow");
static_assert((size_t)1024 * 16 * 512 * 2 <= SZ_WD, "OLAT overflow");
static_assert((size_t)1024 * 16 * 640 * 2 <= (size_t)6400 * 2048 * 2, "QABS overflow");
static_assert((size_t)16384 * 1152 * 2 <= SZ_WGU, "P overflow");

constexpr size_t OUT_Y = 0;
constexpr size_t OUT_CKV_P = 18874368, OUT_KR_P = 23068672, OUT_POOL_P = 23592960, OUT_CKV_S = 23654400, OUT_KR_S = 24178688, OUT_POOL_S = 24244224;

struct Params {
    const float* in[26];
    float* out;
    unsigned char* ws;
    int ph_lo, ph_hi;
};

typedef __bf16 bf16x2_t __attribute__((ext_vector_type(2)));
typedef float f32x2_t __attribute__((ext_vector_type(2)));
DI unsigned cvt_pk_bf16(float lo, float hi) { const f32x2_t v = {lo, hi}; const bf16x2_t b = __builtin_convertvector(v, bf16x2_t); return __builtin_bit_cast(unsigned, b); }
DI float bf2f(unsigned short b) { return __uint_as_float(((unsigned)b) << 16); }
DI float bflo(unsigned w) { return __uint_as_float(w << 16); }
DI float bfhi(unsigned w) { return __uint_as_float(w & 0xffff0000u); }
DI int lane_id() { return (int)__builtin_amdgcn_mbcnt_hi(~0u, __builtin_amdgcn_mbcnt_lo(~0u, 0u)); }
#define TIDX (wv * 64 + lane_id())
DI f32x4 bf4(u32x2 w) { return (f32x4){bflo(w.x), bfhi(w.x), bflo(w.y), bfhi(w.y)}; }
DI float wave_sum(float v) {
#pragma unroll
    for (int o = 32; o > 0; o >>= 1) v += __shfl_xor(v, o);
    return v;
}
DI float wave_max(float v) {
#pragma unroll
    for (int o = 32; o > 0; o >>= 1) v = fmaxf(v, __shfl_xor(v, o));
    return v;
}
DI void rope_cs(int pos, int i, float& c, float& s) {
    const float inv = exp2f(-(float)i * 0.41524101186092029f);
    float rev = (float)pos * inv * 0.15915494309189535f;
    rev = rev - floorf(rev);
    s = __builtin_amdgcn_sinf(rev); c = __builtin_amdgcn_cosf(rev);
}
DI float silu_f(float g) { return g * __builtin_amdgcn_rcpf(1.0f + __builtin_amdgcn_exp2f(-1.4426950408889634f * g)); }
DI float sigmoid_f(float g) { return __builtin_amdgcn_rcpf(1.0f + __builtin_amdgcn_exp2f(-1.4426950408889634f * g)); }

namespace pg8 {
constexpr int BM = 256, BK = 64, HALF = 128, HTB = HALF * BK * 2, STAGE_BYTES = 8 * HTB, NXCD = 8, WGM = 8;
DI int lds_byte(int r, int c) { const int st = (r >> 4) * 2 + (c >> 5), rr = r & 15, cc = c & 31, ob = rr * 64 + cc * 2; return st * 1024 + (ob ^ (((ob >> 9) & 1) << 5)); }
DI void stage_rc(int b, int& R, int& C) { const int st = b / 1024, sb = b % 1024, swz = sb ^ (((sb >> 9) & 1) << 5); R = (st >> 1) * 16 + swz / 64; C = (st & 1) * 32 + (swz % 64) / 2; }
DI int perm32(int rho) { const int n = rho >> 4, i = rho & 15; return 8 * (i >> 2) + 4 * n + (i & 3); }

struct Unit { int pm, pn, bz, kt0, nkt, part; };
struct Gemm {
    const char* A; const char* B;
    int lda, ldb, K;
    int nM, nN, nB;
    long long a_ts, b_ts;
    long long a_bs, b_bs;
    int rot;
    int u0, u1, boff, nblk;
    int split;
};
DI void map_unit(int wgid, int nM, int nN, int nwg, int& pm, int& pn) {
    { const int q = nwg / NXCD, r = nwg % NXCD, xcd = wgid % NXCD, off = wgid / NXCD; wgid = (xcd < r ? xcd * (q + 1) : r * (q + 1) + (xcd - r) * q) + off; }
    const int nig = WGM * nN, gid = wgid / nig, fm = gid * WGM, gsz = (nM - fm) < WGM ? (nM - fm) : WGM;
    pm = fm + ((wgid % nig) % gsz); pn = (wgid % nig) / gsz;
}
struct Order {
    int nM, nN, nB, nwg, G, c, split, ntk, u0, u1;
    DI void init(const Gemm& g) { nM = g.nM; nN = g.nN; nB = g.nB; split = g.split; ntk = g.K / BK; if (split == 1) nM = 32; nwg = nM * nN * nB; u0 = 0; u1 = 0x7fffffff;
        if (g.nblk > 0) { u0 = g.u0; u1 = g.u1; G = g.nblk; c = (int)blockIdx.x - g.boff; if (c < 0 || c >= G) { u0 = 0; u1 = 0; c = 0; } return; } G = gridDim.x; c = (int)((blockIdx.x + (unsigned)g.rot) % gridDim.x); }
    DI bool next(int i, Unit& u) const {
        long L = (long)u0 + (long)i * G + c; if (L >= u1) return false;
        u.kt0 = 0; u.nkt = ntk; u.part = -1;
        if (split == 1 && L >= nwg) {
            L -= nwg; if (L >= 256) return false;
            const int kp = (int)(L & 7), t = (int)(L >> 3); u.pm = 32 + (t & 3); u.pn = t >> 2; u.bz = 0; u.part = kp;
            const int P = ntk >> 1, base = P >> 3, rem = P & 7; u.kt0 = 2 * (kp * base + (kp < rem ? kp : rem)); u.nkt = 2 * (base + (kp < rem ? 1 : 0));
            return true;
        }
        if (split == 2) {
            const int full = (nwg / G) * G, left = nwg - full;
            if (L >= full) { const int qd = (int)L - full; if (qd >= 4 * left) return false;
                map_unit(full + (qd >> 2), nM, nN, nwg, u.pm, u.pn); u.bz = qd >> 2; u.part = qd & 3; u.nkt = ntk >> 2; u.kt0 = u.part * u.nkt; return true; }
        }
        if (L >= nwg) return false;
        int wgid = (int)L;
        if (nB == 1) {
            map_unit(wgid, nM, nN, nwg, u.pm, u.pn); u.bz = 0;
        } else {
            const int per = nM * nN; u.bz = wgid / per; const int rem = wgid - u.bz * per; u.pm = rem % nM; u.pn = rem / nM;
        }
        return true;
    }
};

template <class Epi>
DI void gemm_phase(LAS unsigned char* lds, const Gemm g, const Epi& E, const int wv) {
    const int wid = wv, lane = lane_id(), tid = wid * 64 + lane, wr = wid >> 2, wc = wid & 3, fr = lane & 15, fq = lane >> 4;
    Order S; S.init(g);
    unsigned voffA[2], voffB[2];
#pragma unroll
    for (int i = 0; i < 2; ++i) { int R, C; stage_rc(tid * 16 + i * 8192, R, C); const int Rb = Epi::PERM ? ((R & ~31) + perm32(R & 31)) : R;
        voffA[i] = (unsigned)(R * g.lda + C) * 2u; voffB[i] = (unsigned)(Rb * g.ldb + C) * 2u; }
    const size_t kstep = (size_t)(BK * 2);
    const size_t hstepA = (size_t)HALF * g.lda * 2, hstepB = (size_t)HALF * g.ldb * 2;
    const unsigned ldsw = (unsigned)wid * 1024u;
    const int aoff = lds_byte(wr * 64 + fr, fq * 8), boff = lds_byte(wc * 32 + fr, fq * 8);
#define PG8_SA(b, h) (((b) * 2 + (h)) * HTB)
#define PG8_SB(b, h) ((4 + (b) * 2 + (h)) * HTB)
#define PG8_STAGE(bufoff, gbase, voff) do { _Pragma("unroll") for (int _i = 0; _i < 2; ++_i) \
        __builtin_amdgcn_global_load_lds((const unsigned*)((const char*)(gbase) + (voff)[_i]), (LAS unsigned*)(lds + (bufoff) + ldsw + _i * 8192), 16, 0, 0); } while (0)
#define PG8_LDA(dst, b, h) do { _Pragma("unroll") for (int m = 0; m < 4; ++m) _Pragma("unroll") for (int k = 0; k < 2; ++k) dst[m][k] = *(const LAS bf16x8*)(lds + PG8_SA(b, h) + aoff + m * 2048 + k * 1024); } while (0)
#define PG8_LDB(dst, b, h) do { _Pragma("unroll") for (int n = 0; n < 2; ++n) _Pragma("unroll") for (int k = 0; k < 2; ++k) dst[n][k] = *(const LAS bf16x8*)(lds + PG8_SB(b, h) + boff + n * 2048 + k * 1024); } while (0)
#define PG8_MMA(ai, bj, At, Bt) do { __builtin_amdgcn_s_setprio(1); _Pragma("unroll") for (int m = 0; m < 4; ++m) _Pragma("unroll") for (int n = 0; n < 2; ++n) _Pragma("unroll") for (int k = 0; k < 2; ++k) \
        acc[ai][bj][m][n] = __builtin_amdgcn_mfma_f32_16x16x32_bf16(Bt[n][k], At[m][k], acc[ai][bj][m][n], 0, 0, 0); __builtin_amdgcn_s_setprio(0); } while (0)
#define PG8_WAIT_V(n) asm volatile("s_waitcnt vmcnt(" #n ")" ::: "memory")
#define PG8_WAIT_L(n) asm volatile("s_waitcnt lgkmcnt(" #n ")" ::: "memory")
#define PG8_BAR __builtin_amdgcn_s_barrier()
#define PG8_SCHED __builtin_amdgcn_sched_barrier(0)
    Unit cur, nxt; int ui = 0;
    if (!S.next(0, cur)) return;
    f32x4 acc[2][2][4][2];
#pragma unroll
    for (int a = 0; a < 2; ++a)
#pragma unroll
        for (int b = 0; b < 2; ++b)
#pragma unroll
            for (int m = 0; m < 4; ++m)
#pragma unroll
                for (int n = 0; n < 2; ++n) acc[a][b][m][n] = (f32x4){0.f, 0.f, 0.f, 0.f};
    bf16x8 At[4][2], B0[2][2], B1[2][2];
    const char* cA = g.A + (size_t)cur.bz * g.a_bs + (size_t)cur.pm * g.a_ts + (size_t)cur.kt0 * kstep; const char* cB = g.B + (size_t)cur.bz * g.b_bs + (size_t)cur.pn * g.b_ts + (size_t)cur.kt0 * kstep;
    PG8_STAGE(PG8_SB(0, 0), cB, voffB); PG8_STAGE(PG8_SA(0, 0), cA, voffA); PG8_STAGE(PG8_SB(0, 1), cB + hstepB, voffB); PG8_STAGE(PG8_SA(0, 1), cA + hstepA, voffA);
    if (wr == 1) PG8_BAR;
    PG8_WAIT_V(4); PG8_BAR;
    PG8_STAGE(PG8_SB(1, 0), cB + kstep, voffB); PG8_STAGE(PG8_SA(1, 0), cA + kstep, voffA); PG8_STAGE(PG8_SB(1, 1), cB + hstepB + kstep, voffB);
    PG8_WAIT_V(6); PG8_BAR;
    for (;;) {
        const bool has_next = S.next(ui + 1, nxt);
        const char* nA = has_next ? g.A + (size_t)nxt.bz * g.a_bs + (size_t)nxt.pm * g.a_ts + (size_t)nxt.kt0 * kstep : cA; const char* nB = has_next ? g.B + (size_t)nxt.bz * g.b_bs + (size_t)nxt.pn * g.b_ts + (size_t)nxt.kt0 * kstep : cB;
        const int nt = cur.nkt;
        for (int t = 0; t < nt; t += 2) {
            const bool last = (t == nt - 2);
            const char* a1 = cA + (size_t)(t + 1) * kstep;
            const char* a2 = last ? nA : cA + (size_t)(t + 2) * kstep; const char* b2 = last ? nB : cB + (size_t)(t + 2) * kstep;
            const char* a3 = a2 + kstep; const char* b3 = b2 + kstep;
            PG8_LDB(B0, 0, 0); PG8_SCHED; PG8_LDA(At, 0, 0); PG8_STAGE(PG8_SA(1, 1), a1 + hstepA, voffA);
            PG8_WAIT_L(8); PG8_BAR; PG8_WAIT_L(0); PG8_MMA(0, 0, At, B0); PG8_BAR; PG8_SCHED;
            PG8_LDB(B1, 0, 1); PG8_STAGE(PG8_SB(0, 0), b2, voffB);
            PG8_BAR; PG8_WAIT_L(0); PG8_MMA(0, 1, At, B1); PG8_BAR;
            PG8_LDA(At, 0, 1); PG8_STAGE(PG8_SA(0, 0), a2, voffA);
            PG8_BAR; PG8_WAIT_L(0); PG8_MMA(1, 0, At, B0); PG8_BAR; PG8_SCHED;
            PG8_STAGE(PG8_SB(0, 1), b2 + hstepB, voffB);
            PG8_WAIT_V(6); PG8_BAR; PG8_MMA(1, 1, At, B1); PG8_BAR;
            PG8_LDB(B0, 1, 0); PG8_SCHED; PG8_LDA(At, 1, 0); PG8_STAGE(PG8_SA(0, 1), a2 + hstepA, voffA);
            PG8_WAIT_L(8); PG8_BAR; PG8_WAIT_L(0); PG8_MMA(0, 0, At, B0); PG8_BAR; PG8_SCHED;
            PG8_LDB(B1, 1, 1); PG8_STAGE(PG8_SB(1, 0), b3, voffB);
            PG8_BAR; PG8_WAIT_L(0); PG8_MMA(0, 1, At, B1); PG8_BAR;
            PG8_LDA(At, 1, 1); PG8_STAGE(PG8_SA(1, 0), a3, voffA);
            PG8_BAR; PG8_WAIT_L(0); PG8_MMA(1, 0, At, B0); PG8_BAR; PG8_SCHED;
            PG8_STAGE(PG8_SB(1, 1), b3 + hstepB, voffB);
            PG8_WAIT_V(6); PG8_BAR; PG8_MMA(1, 1, At, B1); PG8_BAR;
        }
        E(acc, cur, wr, wc, fr, fq);
        if (!has_next) break;
#pragma unroll
        for (int a = 0; a < 2; ++a)
#pragma unroll
            for (int b = 0; b < 2; ++b)
#pragma unroll
                for (int m = 0; m < 4; ++m)
#pragma unroll
                    for (int n = 0; n < 2; ++n) acc[a][b][m][n] = (f32x4){0.f, 0.f, 0.f, 0.f};
        cur = nxt; cA = nA; cB = nB; ++ui;
    }
    PG8_WAIT_V(0);
    if (wr == 0) PG8_BAR;
    PG8_BAR;
#undef PG8_SA
#undef PG8_SB
#undef PG8_STAGE
#undef PG8_LDA
#undef PG8_LDB
#undef PG8_MMA
#undef PG8_WAIT_V
#undef PG8_WAIT_L
#undef PG8_BAR
#undef PG8_SCHED
}

typedef f32x4 Acc[2][2][4][2];
#define EPI_ROWS  _Pragma("unroll") for (int ai = 0; ai < 2; ++ai) _Pragma("unroll") for (int m = 0; m < 4; ++m)

struct EpiSwiglu {
    static constexpr bool PERM = true;
    bf16_t* G; float* slab;
    DI void operator()(const Acc& acc, const Unit& u, int wr, int wc, int fr, int fq) const {
        if (u.part >= 0) {
            bf16_t* sp = (bf16_t*)slab + ((size_t)(u.bz * 4 + u.part) * 32 * 512 + (size_t)((wr * 4 + wc) * 64 + fq * 16 + fr)) * 4;
#pragma unroll
            for (int ai = 0; ai < 2; ++ai)
#pragma unroll
                for (int bj = 0; bj < 2; ++bj)
#pragma unroll
                    for (int m = 0; m < 4; ++m)
#pragma unroll
                        for (int n = 0; n < 2; ++n) { const f32x4 t = acc[ai][bj][m][n]; u32x2 w; w.x = cvt_pk_bf16(t[0], t[1]); w.y = cvt_pk_bf16(t[2], t[3]);
                            *(u32x2*)(sp + (size_t)(((ai * 2 + bj) * 4 + m) * 2 + n) * 2048) = w; }
            return;
        }
        const int row0 = u.pm * BM + wr * 64 + fr, col0 = u.pn * 128 + wc * 32 + 8 * fq;
        EPI_ROWS { bf16_t* rp = G + (size_t)(row0 + ai * HALF + m * 16) * DFF + col0;
            const f32x4 g0 = acc[ai][0][m][0], g1 = acc[ai][0][m][1], u0 = acc[ai][1][m][0], u1 = acc[ai][1][m][1];
            u32x4 w; w.x = cvt_pk_bf16(silu_f(g0[0]) * u0[0], silu_f(g0[1]) * u0[1]); w.y = cvt_pk_bf16(silu_f(g0[2]) * u0[2], silu_f(g0[3]) * u0[3]);
            w.z = cvt_pk_bf16(silu_f(g1[0]) * u1[0], silu_f(g1[1]) * u1[1]); w.w = cvt_pk_bf16(silu_f(g1[2]) * u1[2], silu_f(g1[3]) * u1[3]);
            *(u32x4*)rp = w; }
    }
};
struct EpiResid {
    static constexpr bool PERM = false;
    float* out; const float* resP; const float* resS; float scale; float* slab;
    const bf16_t* resB; bf16_t* outB;
    DI void operator()(const Acc& acc, const Unit& u, int wr, int wc, int fr, int fq) const {
        const int row0 = u.pm * BM + wr * 64 + fr, col0 = u.pn * BM + wc * 32 + 4 * fq;
        if (u.part >= 0) {
            EPI_ROWS { bf16_t* op = (bf16_t*)slab + ((size_t)u.part * NST + (size_t)(row0 + ai * HALF + m * 16 - NPT)) * DM + col0;
#pragma unroll
                for (int bj = 0; bj < 2; ++bj)
#pragma unroll
                    for (int n = 0; n < 2; ++n) { const f32x4 t = acc[ai][bj][m][n] * scale; u32x2 w; w.x = cvt_pk_bf16(t[0], t[1]); w.y = cvt_pk_bf16(t[2], t[3]); *(u32x2*)(op + bj * HALF + n * 16) = w; } }
            return;
        }
        const float* rb = (u.pm * BM < NPT ? resP : resS - (size_t)NPT * DM) + col0; float* ob = out + col0;
#define ER_ROW(b, mm) ((size_t)(row0 + ((b) >> 1) * HALF + (2 * ((b) & 1) + (mm)) * 16) * DM)
#define ER_LD(R, b) do { _Pragma("unroll") for (int mm = 0; mm < 2; ++mm) _Pragma("unroll") for (int bj = 0; bj < 2; ++bj) _Pragma("unroll") for (int n = 0; n < 2; ++n) { \
            if (resB != nullptr) { const u32x2 w_ = *(const u32x2*)(resB + ER_ROW(b, mm) + col0 + bj * HALF + n * 16); R[mm][bj][n] = (f32x4){__uint_as_float(w_.x), __uint_as_float(w_.y), 0.f, 0.f}; } \
            else R[mm][bj][n] = *(const f32x4*)(rb + ER_ROW(b, mm) + bj * HALF + n * 16); } } while (0)
#define ER_ST(R, b) do { _Pragma("unroll") for (int mm = 0; mm < 2; ++mm) _Pragma("unroll") for (int bj = 0; bj < 2; ++bj) _Pragma("unroll") for (int n = 0; n < 2; ++n) { \
            f32x4 r_ = R[mm][bj][n]; if (resB != nullptr) { const unsigned w0_ = __float_as_uint(r_[0]), w1_ = __float_as_uint(r_[1]); r_ = (f32x4){bflo(w0_), bfhi(w0_), bflo(w1_), bfhi(w1_)}; } \
            const f32x4 hv_ = r_ + acc[(b) >> 1][bj][2 * ((b) & 1) + mm][n] * scale; \
            if (outB != nullptr) { u32x2 w_; w_.x = cvt_pk_bf16(hv_[0], hv_[1]); w_.y = cvt_pk_bf16(hv_[2], hv_[3]); *(u32x2*)(outB + ER_ROW(b, mm) + col0 + bj * HALF + n * 16) = w_; } \
            else *(f32x4*)(ob + ER_ROW(b, mm) + bj * HALF + n * 16) = hv_; } } while (0)
        f32x4 ra[2][2][2], rc[2][2][2];
        ER_LD(ra, 0); ER_LD(rc, 1); ER_ST(ra, 0); ER_LD(ra, 2); ER_ST(rc, 1); ER_LD(rc, 3); ER_ST(ra, 2); ER_ST(rc, 3);
#undef ER_ROW
#undef ER_LD
#undef ER_ST
    }
};
struct EpiBf16 {
    static constexpr bool PERM = true;
    bf16_t* O; int ld; long long bs; float scale; int half_only;
    DI void operator()(const Acc& acc, const Unit& u, int wr, int wc, int fr, int fq) const {
        const int row0 = u.pm * BM + wr * 64 + fr, col0 = u.pn * (half_only ? 128 : BM) + wc * 32 + 8 * fq;
        bf16_t* base = O + (size_t)u.bz * bs;
        EPI_ROWS { bf16_t* rp = base + (size_t)(row0 + ai * HALF + m * 16) * ld + col0;
#pragma unroll
            for (int bj = 0; bj < 2; ++bj) { if (bj == 1 && half_only) continue;
                const f32x4 v0 = acc[ai][bj][m][0] * scale, v1 = acc[ai][bj][m][1] * scale;
                u32x4 w; w.x = cvt_pk_bf16(v0[0], v0[1]); w.y = cvt_pk_bf16(v0[2], v0[3]); w.z = cvt_pk_bf16(v1[0], v1[1]); w.w = cvt_pk_bf16(v1[2], v1[3]);
                *(u32x4*)(rp + bj * HALF) = w; } }
    }
};
struct EpiScore {
    static constexpr bool PERM = false;
    _Float16* S;
    DI void operator()(const Acc& acc, const Unit& u, int wr, int wc, int fr, int fq) const {
        const int row0 = u.bz * 512 + u.pm * BM + wr * 64 + fr, col0 = u.pn * BM + wc * 32 + 4 * fq;
        EPI_ROWS { _Float16* op = S + (size_t)(row0 + ai * HALF + m * 16) * 1056 + col0;
#pragma unroll
            for (int bj = 0; bj < 2; ++bj)
#pragma unroll
                for (int n = 0; n < 2; ++n) { if (col0 + bj * HALF + n * 16 < 1056) *(u32x2*)(op + bj * HALF + n * 16) = __builtin_bit_cast(u32x2, __builtin_convertvector(acc[ai][bj][m][n], f16x4)); } }
    }
};
struct EpiWin {
    static constexpr bool PERM = true;
    float* Z; float* QLR; float* CKR; bf16_t* GATES; bf16_t* KRB; float* outKrP; float* outKrS; float* outPoolP; float* outPoolS;
    DI void operator()(const Acc& acc, const Unit& u, int wr, int wc, int fr, int fq) const {
        const int row0 = u.pm * BM + wr * 64 + fr, cw = wc * 32 + 8 * fq;
        if (u.pn < 6) {
            bf16_t* base; int ld, c0;
            if (u.pn < 4) { base = (bf16_t*)Z; ld = 1024; c0 = u.pn * 256; } else { base = (bf16_t*)QLR; ld = 512; c0 = (u.pn - 4) * 256; }
            EPI_ROWS { const int row = row0 + ai * HALF + m * 16; bf16_t* op = base + (size_t)row * ld + c0 + cw;
#pragma unroll
                for (int bj = 0; bj < 2; ++bj) { const f32x4 v0 = acc[ai][bj][m][0], v1 = acc[ai][bj][m][1];
                    u32x4 w; w.x = cvt_pk_bf16(v0[0], v0[1]); w.y = cvt_pk_bf16(v0[2], v0[3]); w.z = cvt_pk_bf16(v1[0], v1[1]); w.w = cvt_pk_bf16(v1[2], v1[3]);
                    *(u32x4*)(op + bj * HALF) = w; }
                if (u.pn < 4) {
                    float* pf = nullptr;
                    if (row < NPT) { const int t = row & 2047; if (t >= 2033) pf = outPoolP + ((size_t)(row >> 11) * 15 + (t - 2033)) * 1024; }
                    else { const int rs = row - NPT, t = rs & 31; if (t >= 17) pf = outPoolS + ((size_t)(rs >> 5) * 15 + (t - 17)) * 1024; }
                    if (pf != nullptr) {
#pragma unroll
                        for (int bj = 0; bj < 2; ++bj) { *(f32x4*)(pf + c0 + cw + bj * HALF) = acc[ai][bj][m][0]; *(f32x4*)(pf + c0 + cw + bj * HALF + 4) = acc[ai][bj][m][1]; } } } }
        } else if (u.pn < 8) {
            const int c0 = (u.pn - 6) * 256;
            EPI_ROWS { float* op = CKR + (size_t)(row0 + ai * HALF + m * 16) * 512 + c0 + cw;
#pragma unroll
                for (int bj = 0; bj < 2; ++bj) { *(f32x4*)(op + bj * HALF) = acc[ai][bj][m][0]; *(f32x4*)(op + bj * HALF + 4) = acc[ai][bj][m][1]; } }
        } else if (u.pn < 24) {
            const int c0 = (u.pn - 8) * 256 + cw;
            EPI_ROWS { bf16_t* op = GATES + (size_t)(row0 + ai * HALF + m * 16) * 4096 + c0;
#pragma unroll
                for (int bj = 0; bj < 2; ++bj) { const f32x4 v0 = acc[ai][bj][m][0], v1 = acc[ai][bj][m][1];
                    u32x4 w; w.x = cvt_pk_bf16(sigmoid_f(v0[0]), sigmoid_f(v0[1])); w.y = cvt_pk_bf16(sigmoid_f(v0[2]), sigmoid_f(v0[3]));
                    w.z = cvt_pk_bf16(sigmoid_f(v1[0]), sigmoid_f(v1[1])); w.w = cvt_pk_bf16(sigmoid_f(v1[2]), sigmoid_f(v1[3]));
                    *(u32x4*)(op + bj * HALF) = w; } }
        } else if (wc == 0) {
            EPI_ROWS { const int row = row0 + ai * HALF + m * 16;
                const int pos = row < NPT ? (row & 2047) : 1024 + ((row - NPT) & 31);
                float* of = row < NPT ? outKrP + (size_t)row * 64 : outKrS + (size_t)(row - NPT) * 64;
                bf16_t* ob = KRB + (size_t)row * 64;
                float o1[8], o2[8];
#pragma unroll
                for (int n = 0; n < 2; ++n)
#pragma unroll
                    for (int j = 0; j < 4; ++j) { float c, s; rope_cs(pos, 8 * fq + 4 * n + j, c, s); const float x1 = acc[ai][0][m][n][j], x2 = acc[ai][1][m][n][j];
                        o1[4 * n + j] = x1 * c - x2 * s; o2[4 * n + j] = x2 * c + x1 * s; }
                *(f32x4*)(of + 8 * fq) = (f32x4){o1[0], o1[1], o1[2], o1[3]}; *(f32x4*)(of + 8 * fq + 4) = (f32x4){o1[4], o1[5], o1[6], o1[7]};
                *(f32x4*)(of + 32 + 8 * fq) = (f32x4){o2[0], o2[1], o2[2], o2[3]}; *(f32x4*)(of + 32 + 8 * fq + 4) = (f32x4){o2[4], o2[5], o2[6], o2[7]};
                u32x4 w1, w2; w1.x = cvt_pk_bf16(o1[0], o1[1]); w1.y = cvt_pk_bf16(o1[2], o1[3]); w1.z = cvt_pk_bf16(o1[4], o1[5]); w1.w = cvt_pk_bf16(o1[6], o1[7]);
                w2.x = cvt_pk_bf16(o2[0], o2[1]); w2.y = cvt_pk_bf16(o2[2], o2[3]); w2.z = cvt_pk_bf16(o2[4], o2[5]); w2.w = cvt_pk_bf16(o2[6], o2[7]);
                *(u32x4*)(ob + 8 * fq) = w1; *(u32x4*)(ob + 32 + 8 * fq) = w2; }
        }
    }
};
struct EpiQ {
    static constexpr bool PERM = true;
    bf16_t* QN; bf16_t* QR; bf16_t* QABS;
    DI void operator()(const Acc& acc, const Unit& u, int wr, int wc, int fr, int fq) const {
        const int row0 = u.pm * BM + wr * 64 + fr;
        if (u.pn < 8) {
            const int col0 = u.pn * BM + wc * 32 + 8 * fq;
            EPI_ROWS { bf16_t* rp = QN + (size_t)(row0 + ai * HALF + m * 16) * 2048 + col0;
#pragma unroll
                for (int bj = 0; bj < 2; ++bj) { const f32x4 v0 = acc[ai][bj][m][0] * QSCALE, v1 = acc[ai][bj][m][1] * QSCALE;
                    u32x4 w; w.x = cvt_pk_bf16(v0[0], v0[1]); w.y = cvt_pk_bf16(v0[2], v0[3]); w.z = cvt_pk_bf16(v1[0], v1[1]); w.w = cvt_pk_bf16(v1[2], v1[3]);
                    *(u32x4*)(rp + bj * HALF) = w; } }
        } else {
            const int head = 4 * (u.pn - 8) + wc;
            EPI_ROWS { const int row = row0 + ai * HALF + m * 16;
                const int pos = row < NPT ? (row & 2047) : 1024 + ((row - NPT) & 31);
                float o1[8], o2[8];
#pragma unroll
                for (int n = 0; n < 2; ++n)
#pragma unroll
                    for (int j = 0; j < 4; ++j) { float c, s; rope_cs(pos, 8 * fq + 4 * n + j, c, s); const float x1 = acc[ai][0][m][n][j] * QSCALE, x2 = acc[ai][1][m][n][j] * QSCALE;
                        o1[4 * n + j] = x1 * c - x2 * s; o2[4 * n + j] = x2 * c + x1 * s; }
                u32x4 w1, w2; w1.x = cvt_pk_bf16(o1[0], o1[1]); w1.y = cvt_pk_bf16(o1[2], o1[3]); w1.z = cvt_pk_bf16(o1[4], o1[5]); w1.w = cvt_pk_bf16(o1[6], o1[7]);
                w2.x = cvt_pk_bf16(o2[0], o2[1]); w2.y = cvt_pk_bf16(o2[2], o2[3]); w2.z = cvt_pk_bf16(o2[4], o2[5]); w2.w = cvt_pk_bf16(o2[6], o2[7]);
                if (row < NPT) { bf16_t* ob = QR + (size_t)row * 1024 + head * 64; *(u32x4*)(ob + 8 * fq) = w1; *(u32x4*)(ob + 32 + 8 * fq) = w2; }
                else { bf16_t* ob = QABS + ((size_t)(row - NPT) * 16 + head) * 640 + 512; const u32x4 z = (u32x4){0u, 0u, 0u, 0u};
                    *(u32x4*)(ob + 8 * fq) = w1; *(u32x4*)(ob + 32 + 8 * fq) = w2; *(u32x4*)(ob + 64 + 8 * fq) = z; *(u32x4*)(ob + 96 + 8 * fq) = z; } }
        }
    }
};
struct EpiPoolMix {
    static constexpr bool PERM = true;
    bf16_t* MIXED; const float* pscale;
    DI void operator()(const Acc& acc, const Unit& u, int wr, int wc, int fr, int fq) const {
        const int row0 = u.pm * BM + wr * 64 + fr, col0 = u.bz * 256 + wc * 32 + 8 * fq;
        f32x4 sc[2][2];
#pragma unroll
        for (int bj = 0; bj < 2; ++bj) { sc[bj][0] = *(const f32x4*)(pscale + col0 + bj * HALF); sc[bj][1] = *(const f32x4*)(pscale + col0 + bj * HALF + 4); }
        EPI_ROWS { bf16_t* rp = MIXED + (size_t)(row0 + ai * HALF + m * 16) * 1024 + col0;
#pragma unroll
            for (int bj = 0; bj < 2; ++bj) { const f32x4 v0 = acc[ai][bj][m][0] * sc[bj][0], v1 = acc[ai][bj][m][1] * sc[bj][1];
                u32x4 w; w.x = cvt_pk_bf16(v0[0], v0[1]); w.y = cvt_pk_bf16(v0[2], v0[3]); w.z = cvt_pk_bf16(v1[0], v1[1]); w.w = cvt_pk_bf16(v1[2], v1[3]);
                *(u32x4*)(rp + bj * HALF) = w; } }
    }
};
struct EpiGate {
    static constexpr bool PERM = true;
    bf16_t* OUT; const bf16_t* GATES; const bf16_t* ADD; int goff; int mode;
    DI void operator()(const Acc& acc, const Unit& u, int wr, int wc, int fr, int fq) const {
        const int row0 = u.pm * BM + wr * 64 + fr, col0 = u.pn * BM + wc * 32 + 8 * fq;
#define EG_ROW(b, mm) ((size_t)(row0 + ((b) >> 1) * HALF + (2 * ((b) & 1) + (mm)) * 16))
#define EG_LD(GW, AW, b) do { _Pragma("unroll") for (int mm = 0; mm < 2; ++mm) _Pragma("unroll") for (int bj = 0; bj < 2; ++bj) { const int c = col0 + bj * HALF; \
            GW[mm][bj] = *(const u32x4*)(GATES + EG_ROW(b, mm) * 4096 + goff + c); AW[mm][bj] = (u32x4){0u, 0u, 0u, 0u}; if (mode) AW[mm][bj] = *(const u32x4*)(ADD + EG_ROW(b, mm) * 2048 + c); } } while (0)
#define EG_ST(GW, AW, b) do { _Pragma("unroll") for (int mm = 0; mm < 2; ++mm) _Pragma("unroll") for (int bj = 0; bj < 2; ++bj) { const int c = col0 + bj * HALF; \
            const u32x4 gw = GW[mm][bj], aw = AW[mm][bj]; const f32x4 a0 = acc[(b) >> 1][bj][2 * ((b) & 1) + mm][0], a1 = acc[(b) >> 1][bj][2 * ((b) & 1) + mm][1]; \
            u32x4 w; w.x = cvt_pk_bf16(bflo(aw.x) + bflo(gw.x) * a0[0], bfhi(aw.x) + bfhi(gw.x) * a0[1]); w.y = cvt_pk_bf16(bflo(aw.y) + bflo(gw.y) * a0[2], bfhi(aw.y) + bfhi(gw.y) * a0[3]); \
            w.z = cvt_pk_bf16(bflo(aw.z) + bflo(gw.z) * a1[0], bfhi(aw.z) + bfhi(gw.z) * a1[1]); w.w = cvt_pk_bf16(bflo(aw.w) + bflo(gw.w) * a1[2], bfhi(aw.w) + bfhi(gw.w) * a1[3]); \
            *(u32x4*)(OUT + EG_ROW(b, mm) * 2048 + c) = w; } } while (0)
        u32x4 ga[2][2], aa[2][2], gb[2][2], ab[2][2];
        EG_LD(ga, aa, 0); EG_LD(gb, ab, 1); EG_ST(ga, aa, 0); EG_LD(ga, aa, 2); EG_ST(gb, ab, 1); EG_LD(gb, ab, 3); EG_ST(ga, aa, 2); EG_ST(gb, ab, 3);
#undef EG_ROW
#undef EG_LD
#undef EG_ST
    }
};
}

template <int MAP> DI int maprow(int n) {
    if (MAP == 1) return 256 * (n >> 7) + (n & 127);
    if (MAP == 2) return 256 * (n >> 7) + 128 + (n & 127);
    if (MAP == 3) { if (n < 2048) return n; if (n < 2112) { const int i = n - 2048; return 6144 + (i >> 5) * 128 + (i & 31); } return n - 64; }
    if (MAP == 4) { const int h = n / 192, d = n - h * 192; if (d < 128) return h * 128 + d; const int i = d - 128; return 256 * (8 + (h >> 2)) + (i >> 5) * 128 + (h & 3) * 32 + (i & 31); }
    return n;
}
template <int MAP> DI void convT(const float* __restrict__ src, int ldsrc, int K, int N, bf16_t* __restrict__ dst, int ldd, float* sm, int blk, int nblk, const int wv, bf16_t* __restrict__ rowdst = nullptr, int ldr = 0) {
    const int tid = TIDX, ntk = K >> 7, ntn = N >> 6, ntile = ntk * ntn;
    const int rr = tid >> 4, c4 = (tid & 15) * 4;
    f32x4 v[4], n1[4], n2[4];
#define CT_LOAD(dstv, t) do { const int kt_ = (t) % ntk, nt_ = (t) / ntk; const float* sp_ = src + (size_t)(kt_ * 128 + rr) * ldsrc + nt_ * 64 + c4; \
        _Pragma("unroll") for (int q = 0; q < 4; ++q) dstv[q] = *(const f32x4*)(sp_ + (size_t)(32 * q) * ldsrc); } while (0)
    int tile = blk;
    if (tile < ntile) CT_LOAD(v, tile);
    if (tile + nblk < ntile) CT_LOAD(n1, tile + nblk);
    for (; tile < ntile; tile += nblk) {
        const int kt = tile % ntk, nt = tile / ntk;
        if (tile + 2 * nblk < ntile) CT_LOAD(n2, tile + 2 * nblk);
#pragma unroll
        for (int q = 0; q < 4; ++q)
#pragma unroll
            for (int e = 0; e < 4; ++e) sm[(c4 + e) * 132 + rr + 32 * q] = v[q][e];
        if (rowdst != nullptr) {
#pragma unroll
            for (int q = 0; q < 4; ++q) { u32x2 w; w.x = cvt_pk_bf16(v[q][0], v[q][1]); w.y = cvt_pk_bf16(v[q][2], v[q][3]); *(u32x2*)(rowdst + (size_t)(kt * 128 + rr + 32 * q) * ldr + nt * 64 + c4) = w; } }
        __syncthreads();
#pragma unroll
        for (int u = 0; u < 2; ++u) { const int id = tid + 512 * u, wn = id >> 4, k8 = (id & 15) * 8;
            const f32x4 a = *(const f32x4*)(sm + wn * 132 + k8), b = *(const f32x4*)(sm + wn * 132 + k8 + 4);
            u32x4 w; w.x = cvt_pk_bf16(a[0], a[1]); w.y = cvt_pk_bf16(a[2], a[3]); w.z = cvt_pk_bf16(b[0], b[1]); w.w = cvt_pk_bf16(b[2], b[3]);
            *(u32x4*)(dst + (size_t)maprow<MAP>(nt * 64 + wn) * ldd + kt * 128 + k8) = w; }
        __syncthreads();
#pragma unroll
        for (int q = 0; q < 4; ++q) { v[q] = n1[q]; n1[q] = n2[q]; }
    }
#undef CT_LOAD
}
DI void rmsnorm_rows_bf16(const float* srcP, const float* srcS, const float* __restrict__ gain, bf16_t* dst, const float* slab, float* hS, const int wv, const bf16_t* srcPB = nullptr) {
    const int lane = lane_id(), gw = blockIdx.x * 8 + wv, nw = gridDim.x * 8;
    for (int r = gw; r < NTOK; r += nw) {
        const float* sp = (r < NPT ? srcP + (size_t)r * DM : srcS + (size_t)(r - NPT) * DM);
        f32x4 v[8]; float ss = 0.f;
        if (srcPB != nullptr && r < NPT) {
#pragma unroll
            for (int i = 0; i < 8; ++i) { const u32x2 w = *(const u32x2*)(srcPB + (size_t)r * DM + i * 256 + lane * 4); v[i] = (f32x4){bflo(w.x), bfhi(w.x), bflo(w.y), bfhi(w.y)}; }
        } else {
#pragma unroll
            for (int i = 0; i < 8; ++i) v[i] = *(const f32x4*)(sp + i * 256 + lane * 4);
        }
        if (slab != nullptr && r >= NPT) {
#pragma unroll
            for (int sidx = 0; sidx < 8; ++sidx) { const bf16_t* sl = (const bf16_t*)slab + ((size_t)sidx * NST + (r - NPT)) * DM;
#pragma unroll
                for (int i = 0; i < 8; ++i) { const u32x2 w = *(const u32x2*)(sl + i * 256 + lane * 4); v[i] += (f32x4){bflo(w.x), bfhi(w.x), bflo(w.y), bfhi(w.y)}; } }
#pragma unroll
            for (int i = 0; i < 8; ++i) *(f32x4*)(hS + (size_t)(r - NPT) * DM + i * 256 + lane * 4) = v[i];
        }
#pragma unroll
        for (int i = 0; i < 8; ++i) ss += v[i][0] * v[i][0] + v[i][1] * v[i][1] + v[i][2] * v[i][2] + v[i][3] * v[i][3];
        ss = wave_sum(ss); const float rstd = rsqrtf(ss * (1.0f / 2048.0f) + 1e-6f);
#pragma unroll
        for (int i = 0; i < 8; ++i) { const f32x4 g = *(const f32x4*)(gain + i * 256 + lane * 4);
            u32x2 w; w.x = cvt_pk_bf16(v[i][0] * rstd * g[0], v[i][1] * rstd * g[1]); w.y = cvt_pk_bf16(v[i][2] * rstd * g[2], v[i][3] * rstd * g[3]);
            *(u32x2*)(dst + (size_t)r * DM + i * 256 + lane * 4) = w; }
    }
}
DI void convert_ffn_weights(const Params& p, unsigned char* ws, int layer, float* sm, const int bi, const int nb, const int wv, const int which = 3) {
    const float* wg = p.in[layer ? 22 : 6]; const float* wu = p.in[layer ? 23 : 7]; const float* wd = p.in[layer ? 24 : 8];
    if (which & 1) { convT<1>(wg, DFF, 2048, DFF, (bf16_t*)(ws + OFF_WGU), 2048, sm, bi, nb, wv);
        convT<2>(wu, DFF, 2048, DFF, (bf16_t*)(ws + OFF_WGU), 2048, sm, bi, nb, wv); }
    if (which & 2) convT<0>(wd, 2048, DFF, 2048, (bf16_t*)(ws + OFF_WD), DFF, sm, bi, nb, wv);
}

DI void convert_other_weights(const Params& p, unsigned char* ws, float* smf, const int bi, const int nb, const int wv) {
            convT<3>(p.in[10], 6208, 2048, 6208, (bf16_t*)(ws + OFF_WIN), 2048, smf, bi, nb, wv);
            convT<4>(p.in[13], 3072, 512, 3072, (bf16_t*)(ws + OFF_WUQ), 512, smf, (bi + 64) % nb, nb, wv);
            convT<0>(p.in[14], 2048, 512, 2048, (bf16_t*)(ws + OFF_WUKT), 512, smf, (bi + 192) % nb, nb, wv);
            convT<0>(p.in[15], 2048, 512, 2048, (bf16_t*)(ws + OFF_WUVT), 512, smf, bi, nb, wv);
            convT<0>(p.in[16], 2048, 2048, 2048, (bf16_t*)(ws + OFF_WOA), 2048, smf, bi, nb, wv);
            for (int g = 0; g < 4; ++g) convT<0>(p.in[17] + (size_t)g * 65536, 256, 256, 256, (bf16_t*)(ws + OFF_WPOOL) + (size_t)g * 65536, 256, smf, (bi + 16 * g) % nb, nb, wv);
            convT<0>(p.in[19], 2048, 1024, 2048, (bf16_t*)(ws + OFF_WPO), 1024, smf, (bi + 64) % nb, nb, wv);
            convT<0>(p.in[20], 2048, 2048, 2048, (bf16_t*)(ws + OFF_WOUT), 2048, smf, bi, nb, wv);
            {
                bf16_t* z = (bf16_t*)(ws + OFF_WUVT) + (size_t)2048 * 512;
                for (int i = bi * 512 + TIDX; i < 128 * 512 / 8; i += nb * 512) *(u32x4*)(z + (size_t)i * 8) = (u32x4){0u, 0u, 0u, 0u};
            }
}

DI void phase_token_local(const Params& p, unsigned char* ws, float* sm, const int wv) {
    const int lane = lane_id(), gw = blockIdx.x * 8 + wv, nw = gridDim.x * 8;
    const float* Z = (const float*)(ws + OFF_Z); const float* QLR = (const float*)(ws + OFF_QLR); const float* CKR = (const float*)(ws + OFF_CKR);
    bf16_t* QLAT = (bf16_t*)(ws + OFF_QLAT); bf16_t* CKVP = (bf16_t*)(ws + OFF_CKVP); bf16_t* POOLED = (bf16_t*)(ws + OFF_POOLED);
    bf16_t* KALL = (bf16_t*)(ws + OFF_KALL); bf16_t* CKVT = (bf16_t*)(ws + OFF_CKVT); const bf16_t* KRB = (const bf16_t*)(ws + OFF_KRB);
    const float* gq = p.in[11]; const float* gkv = p.in[12]; const float* spool = p.in[4];
    for (int r = gw; r < NTOK; r += nw) {
        const bool smp = r >= NPT; const int b = smp ? (r - NPT) >> 5 : r >> 11, t = smp ? (r - NPT) & 31 : r & 2047;
        const u32x4 qw = *(const u32x4*)((const bf16_t*)QLR + (size_t)r * 512 + lane * 8); const f32x4 qa = bf4((u32x2){qw.x, qw.y}), qc = bf4((u32x2){qw.z, qw.w});
        const float* cp = CKR + (size_t)r * 512 + lane * 8; f32x4 ca = *(const f32x4*)cp, cc = *(const f32x4*)(cp + 4);
        f32x4 self[4], pv[4];
#pragma unroll
        for (int g = 0; g < 4; ++g) self[g] = bf4(*(const u32x2*)((const bf16_t*)Z + (size_t)r * 1024 + 256 * g + 4 * lane));
#pragma unroll
        for (int g = 0; g < 4; ++g) {
            const int w = 2 << g, c = 256 * g + 4 * lane;
            f32x4 s = self[g];
            for (int j = 1; j < w; ++j) { const int tt = t - j;
                if (tt >= 0) s += bf4(*(const u32x2*)((const bf16_t*)Z + (size_t)(r - j) * 1024 + c));
                else if (smp) s += *(const f32x4*)(spool + ((size_t)b * 15 + 15 + tt) * 1024 + c); }
            const float cnt = smp ? (float)w : (float)(t + 1 < w ? t + 1 : w);
            pv[g] = s * (1.0f / cnt) - self[g];
        }
        float ssq = qa[0] * qa[0] + qa[1] * qa[1] + qa[2] * qa[2] + qa[3] * qa[3] + qc[0] * qc[0] + qc[1] * qc[1] + qc[2] * qc[2] + qc[3] * qc[3];
        float ssc = ca[0] * ca[0] + ca[1] * ca[1] + ca[2] * ca[2] + ca[3] * ca[3] + cc[0] * cc[0] + cc[1] * cc[1] + cc[2] * cc[2] + cc[3] * cc[3];
        ssq = wave_sum(ssq); ssc = wave_sum(ssc);
        const float rq = rsqrtf(ssq * (1.0f / 512.0f) + 1e-6f), rc = rsqrtf(ssc * (1.0f / 512.0f) + 1e-6f);
        const f32x4 gq0 = *(const f32x4*)(gq + lane * 8), gq1 = *(const f32x4*)(gq + lane * 8 + 4), gk0 = *(const f32x4*)(gkv + lane * 8), gk1 = *(const f32x4*)(gkv + lane * 8 + 4);
        u32x4 krw = (u32x4){0u, 0u, 0u, 0u}; if (smp && lane < 8) krw = *(const u32x4*)(KRB + (size_t)r * 64 + lane * 8);
        {   u32x4 w; w.x = cvt_pk_bf16(qa[0] * rq * gq0[0], qa[1] * rq * gq0[1]); w.y = cvt_pk_bf16(qa[2] * rq * gq0[2], qa[3] * rq * gq0[3]);
            w.z = cvt_pk_bf16(qc[0] * rq * gq1[0], qc[1] * rq * gq1[1]); w.w = cvt_pk_bf16(qc[2] * rq * gq1[2], qc[3] * rq * gq1[3]);
            *(u32x4*)(QLAT + (size_t)r * 512 + lane * 8) = w; }
        {   ca = ca * rc * gk0; cc = cc * rc * gk1;
            float* of = smp ? p.out + OUT_CKV_S + (size_t)(r - NPT) * 512 : p.out + OUT_CKV_P + (size_t)r * 512;
            *(f32x4*)(of + lane * 8) = ca; *(f32x4*)(of + lane * 8 + 4) = cc;
            u32x4 w; w.x = cvt_pk_bf16(ca[0], ca[1]); w.y = cvt_pk_bf16(ca[2], ca[3]); w.z = cvt_pk_bf16(cc[0], cc[1]); w.w = cvt_pk_bf16(cc[2], cc[3]);
            if (!smp) *(u32x4*)(CKVP + (size_t)r * 512 + lane * 8) = w;
            else {
                bf16_t* kr = KALL + ((size_t)b * 1056 + 1024 + t) * 640;
                *(u32x4*)(kr + lane * 8) = w;
                if (lane < 16) *(u32x4*)(kr + 512 + lane * 8) = krw;
                bf16_t* ct = CKVT + ((size_t)b * 512 + lane * 8) * 1152 + 1024 + t;
                ct[0] = (bf16_t)(w.x & 0xffff); ct[1152] = (bf16_t)(w.x >> 16); ct[2 * 1152] = (bf16_t)(w.y & 0xffff); ct[3 * 1152] = (bf16_t)(w.y >> 16);
                ct[4 * 1152] = (bf16_t)(w.z & 0xffff); ct[5 * 1152] = (bf16_t)(w.z >> 16); ct[6 * 1152] = (bf16_t)(w.w & 0xffff); ct[7 * 1152] = (bf16_t)(w.w >> 16);
            } }
#pragma unroll
        for (int g = 0; g < 4; ++g) { const int c = 256 * g + 4 * lane;
            u32x2 o; o.x = cvt_pk_bf16(pv[g][0], pv[g][1]); o.y = cvt_pk_bf16(pv[g][2], pv[g][3]);
            *(u32x2*)(POOLED + (size_t)r * 1024 + c) = o;
            }
    }
}

DI void convert_cache(const Params& p, unsigned char* ws, float* sm, const int bi, const int nb, const int wv) {
    const int lane = lane_id(), gw = bi * 8 + wv, nw = nb * 8;
    bf16_t* KALL = (bf16_t*)(ws + OFF_KALL); bf16_t* CKVT = (bf16_t*)(ws + OFF_CKVT);
    const float* cckv = p.in[2]; const float* ckr = p.in[3];
    for (int r0 = gw * 8; r0 < 32 * 1024; r0 += nw * 8) {
        const int rr = r0 + (lane >> 3), ch = lane & 7, b = rr >> 10, key = rr & 1023;
        const float* s2 = ckr + (size_t)rr * 64 + ch * 8; const f32x4 e = *(const f32x4*)s2, f = *(const f32x4*)(s2 + 4);
        u32x4 w2; w2.x = cvt_pk_bf16(e[0], e[1]); w2.y = cvt_pk_bf16(e[2], e[3]); w2.z = cvt_pk_bf16(f[0], f[1]); w2.w = cvt_pk_bf16(f[2], f[3]);
        bf16_t* kr = KALL + ((size_t)b * 1056 + key) * 640;
        *(u32x4*)(kr + 512 + ch * 8) = w2; *(u32x4*)(kr + 576 + ch * 8) = (u32x4){0u, 0u, 0u, 0u};
    }
    for (int b = 0; b < 32; ++b)
        convT<0>(cckv + (size_t)b * 1024 * 512, 512, 1024, 512, CKVT + (size_t)b * 512 * 1152, 1152, sm, (bi + b * 8) % nb, nb, wv, KALL + (size_t)b * 1056 * 640, 640);
    for (int i = bi * 512 + TIDX; i < 32 * 512 * 12; i += nb * 512) { const int row = i / 12, part = i - row * 12;
        *(u32x4*)(CKVT + (size_t)row * 1152 + 1056 + part * 8) = (u32x4){0u, 0u, 0u, 0u}; }
}

constexpr int ATT_KN = 0, ATT_KR = 16384, ATT_V = 24576, ATT_BUF = 40960;
#define MFMA32(a, b, c) __builtin_amdgcn_mfma_f32_32x32x16_bf16((a), (b), (c), 0, 0, 0)
DI void attn_item(unsigned char* ws, LAS unsigned char* lds, int b, int h, int qt, const int wv) {
    const int wid = wv, lane = lane_id(), tid = wid * 64 + lane, q = lane & 31, g = lane >> 5;
    const bf16_t* QN = (const bf16_t*)(ws + OFF_QN); const bf16_t* QR = (const bf16_t*)(ws + OFF_QR);
    const unsigned char* KN = ws + OFF_KN; const unsigned char* KRB = ws + OFF_KRB; const unsigned char* VT = ws + OFF_VT;
    const int qrow = b * 2048 + qt * 256 + wid * 32 + q;
    bf16x8 qf[12];
    { const bf16_t* qn = QN + (size_t)qrow * 2048 + h * 128 + 8 * g;
#pragma unroll
      for (int s = 0; s < 8; ++s) qf[s] = *(const bf16x8*)(qn + 16 * s);
      const bf16_t* qr = QR + (size_t)qrow * 1024 + h * 64 + 8 * g;
#pragma unroll
      for (int s = 0; s < 4; ++s) qf[8 + s] = *(const bf16x8*)(qr + 16 * s); }
    f32x16 o[4];
#pragma unroll
    for (int d = 0; d < 4; ++d)
#pragma unroll
        for (int i = 0; i < 16; ++i) o[d][i] = 0.f;
    float mrun = -1e30f, lrun = 0.f;
    const int ntiles = 4 * qt + 4, my_last = 4 * qt + (wid >> 1);
    const size_t tok0 = (size_t)b * 2048;
    const int knr = 8 * wid + (lane >> 4), knc = (lane & 15) ^ (knr & 15);
    const int knr1 = knr + 4, knc1 = (lane & 15) ^ (knr1 & 15);
    const int krr = 8 * wid + (lane >> 3), krc = (lane & 7) ^ ((krr >> 1) & 7);
    const int vr = 16 * wid + (lane >> 3), vc = (lane & 7) ^ ((vr >> 1) & 7);
    const int vr1 = vr + 8, vc1 = (lane & 7) ^ ((vr1 >> 1) & 7);
    const unsigned okn0 = (unsigned)(tok0 + knr) * 4096u + h * 256 + knc * 16, okn1 = (unsigned)(tok0 + knr1) * 4096u + h * 256 + knc1 * 16;
    const unsigned okr = (unsigned)(tok0 + krr) * 128u + krc * 16;
    const unsigned ov0 = ((unsigned)(h * 128 + vr) * 8192u + (unsigned)tok0) * 2u + vc * 16, ov1 = ((unsigned)(h * 128 + vr1) * 8192u + (unsigned)tok0) * 2u + vc1 * 16;
#define ATT_DMA(j, buf) do { LAS unsigned char* _b = lds + (buf) * ATT_BUF; const unsigned _j = (unsigned)(j); \
        __builtin_amdgcn_global_load_lds((const unsigned*)(KN + (size_t)(okn0 + _j * 262144u)), (LAS unsigned*)(_b + ATT_KN + wid * 2048), 16, 0, 0); \
        __builtin_amdgcn_global_load_lds((const unsigned*)(KN + (size_t)(okn1 + _j * 262144u)), (LAS unsigned*)(_b + ATT_KN + wid * 2048 + 1024), 16, 0, 0); \
        __builtin_amdgcn_global_load_lds((const unsigned*)(KRB + (size_t)(okr + _j * 8192u)), (LAS unsigned*)(_b + ATT_KR + wid * 1024), 16, 0, 0); \
        __builtin_amdgcn_global_load_lds((const unsigned*)(VT + (size_t)(ov0 + _j * 128u)), (LAS unsigned*)(_b + ATT_V + wid * 2048), 16, 0, 0); \
        __builtin_amdgcn_global_load_lds((const unsigned*)(VT + (size_t)(ov1 + _j * 128u)), (LAS unsigned*)(_b + ATT_V + wid * 2048 + 1024), 16, 0, 0); } while (0)
    ATT_DMA(0, 0);
    asm volatile("s_waitcnt vmcnt(0)" ::: "memory");
    __syncthreads();
    const int krow = (q & ~12) | ((q & 4) << 1) | ((q & 8) >> 1);
    const int kx = krow & 15, ksw = (krow >> 1) & 7, vsw = (q >> 1) & 7;
    const unsigned kn_b = ATT_KN + krow * 256 + ((g ^ kx) & 1) * 16, kn_t = (unsigned)(kx >> 1) << 5;
    const unsigned kr_b = ATT_KR + krow * 128 + ((g ^ ksw) & 1) * 16, kr_t = (unsigned)(ksw >> 1) << 5;
    const unsigned v_b = ATT_V + q * 128 + ((g ^ vsw) & 1) * 16, v_t = (unsigned)(vsw >> 1) << 5;
    const bool grpY = wid >= 4;
    bf16x8 pf[4];
#pragma unroll
    for (int s = 0; s < 4; ++s) pf[s] = (bf16x8){0, 0, 0, 0, 0, 0, 0, 0};
#define ATT_VF(d, s) (*(const LAS bf16x8*)(bb + v_b + (d) * 32 * 128 + (((unsigned)(s) << 5) ^ vtt)))
#define ATT_PV(bufidx) do { LAS unsigned char* bb = lds + (bufidx) * ATT_BUF; unsigned vtt = v_t; asm volatile("" : "+v"(vtt)); \
            bf16x8 va[4], vb[4]; \
            _Pragma("unroll") \
            for (int s = 0; s < 4; ++s) va[s] = ATT_VF(0, s); \
            _Pragma("unroll") \
            for (int s = 0; s < 4; ++s) vb[s] = ATT_VF(1, s); \
            __builtin_amdgcn_sched_barrier(0); \
            _Pragma("unroll") \
            for (int s = 0; s < 4; ++s) o[0] = MFMA32(va[s], pf[s], o[0]); \
            _Pragma("unroll") \
            for (int s = 0; s < 4; ++s) va[s] = ATT_VF(2, s); \
            __builtin_amdgcn_sched_barrier(0); \
            _Pragma("unroll") \
            for (int s = 0; s < 4; ++s) o[1] = MFMA32(vb[s], pf[s], o[1]); \
            _Pragma("unroll") \
            for (int s = 0; s < 4; ++s) vb[s] = ATT_VF(3, s); \
            __builtin_amdgcn_sched_barrier(0); \
            _Pragma("unroll") \
            for (int s = 0; s < 4; ++s) o[2] = MFMA32(va[s], pf[s], o[2]); \
            _Pragma("unroll") \
            for (int s = 0; s < 4; ++s) o[3] = MFMA32(vb[s], pf[s], o[3]); \
        } while (0)
    int bj = 0, bprev = 2;
    for (int j = 0; j < ntiles; ++j) {
        const int bnext = (bj == 2) ? 0 : bj + 1;
        if (j + 1 < ntiles) ATT_DMA(j + 1, bnext);
        if (grpY && j >= 1 && j - 1 <= my_last) ATT_PV(bprev);
        if (j <= my_last) {
            LAS unsigned char* bb = lds + bj * ATT_BUF;
            f32x16 sa[2];
#pragma unroll
            for (int mb = 0; mb < 2; ++mb)
#pragma unroll
                for (int i = 0; i < 16; ++i) sa[mb][i] = 0.f;
            unsigned knt = kn_t, krt = kr_t; asm volatile("" : "+v"(knt), "+v"(krt));
#define ATT_KF(mb, s) (*(const LAS bf16x8*)(bb + ((s) < 8 ? kn_b + (mb) * 32 * 256 + (((unsigned)(s) << 5) ^ knt) : kr_b + (mb) * 32 * 128 + (((unsigned)((s) - 8) << 5) ^ krt))))
            bf16x8 ka[3], kb[3];
#define ATT_LDG(dst, i) do { _Pragma("unroll") for (int s_ = 0; s_ < 3; ++s_) dst[s_] = ATT_KF((i) >> 2, 3 * ((i) & 3) + s_); } while (0)
#define ATT_MMG(src, i) do { _Pragma("unroll") for (int s_ = 0; s_ < 3; ++s_) sa[(i) >> 2] = MFMA32(src[s_], qf[3 * ((i) & 3) + s_], sa[(i) >> 2]); } while (0)
            ATT_LDG(ka, 0); ATT_LDG(kb, 1); __builtin_amdgcn_sched_barrier(0);
            ATT_MMG(ka, 0); ATT_LDG(ka, 2); __builtin_amdgcn_sched_barrier(0);
            ATT_MMG(kb, 1); ATT_LDG(kb, 3); __builtin_amdgcn_sched_barrier(0);
            ATT_MMG(ka, 2); ATT_LDG(ka, 4); __builtin_amdgcn_sched_barrier(0);
            ATT_MMG(kb, 3); ATT_LDG(kb, 5); __builtin_amdgcn_sched_barrier(0);
            ATT_MMG(ka, 4); ATT_LDG(ka, 6); __builtin_amdgcn_sched_barrier(0);
            ATT_MMG(kb, 5); ATT_LDG(kb, 7); __builtin_amdgcn_sched_barrier(0);
            ATT_MMG(ka, 6); ATT_MMG(kb, 7); __builtin_amdgcn_sched_barrier(0);
#undef ATT_LDG
#undef ATT_MMG
#undef ATT_KF
            float mx = sa[0][0];
#pragma unroll
            for (int i = 0; i < 16; ++i) { mx = fmaxf(mx, sa[0][i]); mx = fmaxf(mx, sa[1][i]); }
            mx = fmaxf(mx, __shfl_xor(mx, 32));
            const float mnew = fmaxf(mrun, mx), alpha = __builtin_amdgcn_exp2f(mrun - mnew);
            float ps = 0.f;
#pragma unroll
            for (int mb = 0; mb < 2; ++mb)
#pragma unroll
                for (int i = 0; i < 16; ++i) { const float e = __builtin_amdgcn_exp2f(sa[mb][i] - mnew); sa[mb][i] = e; ps += e; }
            lrun = lrun * alpha + ps; mrun = mnew;
#pragma unroll
            for (int d = 0; d < 4; ++d)
#pragma unroll
                for (int i = 0; i < 16; ++i) o[d][i] *= alpha;
#pragma unroll
            for (int s = 0; s < 4; ++s) { const int mb = s >> 1, o8 = (s & 1) * 8; u32x4 w;
                w.x = cvt_pk_bf16(sa[mb][o8 + 0], sa[mb][o8 + 1]); w.y = cvt_pk_bf16(sa[mb][o8 + 2], sa[mb][o8 + 3]); w.z = cvt_pk_bf16(sa[mb][o8 + 4], sa[mb][o8 + 5]); w.w = cvt_pk_bf16(sa[mb][o8 + 6], sa[mb][o8 + 7]);
                pf[s] = __builtin_bit_cast(bf16x8, w); }
        }
        if (!grpY && j <= my_last) ATT_PV(bj);
        asm volatile("s_waitcnt vmcnt(0)" ::: "memory");
        __syncthreads();
        bprev = bj; bj = bnext;
    }
    if (grpY && ntiles - 1 <= my_last) ATT_PV(bprev);
#undef ATT_PV
#undef ATT_VF
    const float lt = lrun + __shfl_xor(lrun, 32), il = 1.0f / lt;
    bf16_t* op = (bf16_t*)(ws + OFF_O) + (size_t)qrow * 2048 + h * 128 + 4 * g;
#pragma unroll
    for (int d = 0; d < 4; ++d)
#pragma unroll
        for (int i = 0; i < 4; ++i) { u32x2 w; w.x = cvt_pk_bf16(o[d][4 * i] * il, o[d][4 * i + 1] * il); w.y = cvt_pk_bf16(o[d][4 * i + 2] * il, o[d][4 * i + 3] * il);
            *(u32x2*)(op + 32 * d + 8 * i) = w; }
#undef ATT_DMA
}

DI void phase_softmax(unsigned char* ws, const int wv) {
    const _Float16* S = (const _Float16*)(ws + OFF_S); bf16_t* P = (bf16_t*)(ws + OFF_P);
    const int lane = lane_id(), gw = blockIdx.x * 8 + wv, nw = gridDim.x * 8;
    for (int r = gw; r < 16384; r += nw) {
        const _Float16* sp = S + (size_t)r * 1056;
        f32x4 v[5]; float mx = -1e30f;
#pragma unroll
        for (int k = 0; k < 5; ++k) { const int ci = lane + 64 * k; if (ci < 264) { v[k] = __builtin_convertvector(*(const f16x4*)(sp + ci * 4), f32x4); mx = fmaxf(mx, fmaxf(fmaxf(v[k][0], v[k][1]), fmaxf(v[k][2], v[k][3]))); } else v[k] = (f32x4){-1e30f, -1e30f, -1e30f, -1e30f}; }
        mx = wave_max(mx);
        float sum = 0.f;
#pragma unroll
        for (int k = 0; k < 5; ++k) { const int ci = lane + 64 * k;
#pragma unroll
            for (int e = 0; e < 4; ++e) { const float x = (ci < 264) ? __builtin_amdgcn_exp2f(v[k][e] - mx) : 0.f; v[k][e] = x; sum += x; } }
        sum = wave_sum(sum); const float is = 1.0f / sum;
#pragma unroll
        for (int k = 0; k < 5; ++k) { const int ci = lane + 64 * k; if (ci < 288) { u32x2 w; w.x = cvt_pk_bf16(v[k][0] * is, v[k][1] * is); w.y = cvt_pk_bf16(v[k][2] * is, v[k][3] * is);
            *(u32x2*)(P + (size_t)r * 1152 + ci * 4) = w; } }
    }
}


#define XB_TMO      128
#define XB_XCNT(j)  (256  + 64 * (j))
#define XB_XSUB(j)  (1280 + 64 * (j))
#define XB_XGEN(j)  (2304 + 64 * (j))
#define XB_TOP      3328
#define XB_TOPGEN   3392
#define XCD_BAR_WORDS 3456
#define XB_SPIN_CAP (1u << 22)
DI unsigned xb_ld(unsigned* p)              { return __hip_atomic_load(p, __ATOMIC_RELAXED, __HIP_MEMORY_SCOPE_AGENT); }
DI unsigned xb_add(unsigned* p, unsigned v) { return __hip_atomic_fetch_add(p, v, __ATOMIC_RELAXED, __HIP_MEMORY_SCOPE_AGENT); }
DI unsigned xb_xcc_id() { return (unsigned)__builtin_amdgcn_s_getreg((3 << 11) | 20) & 0xFu; }
#define XB_SPIN(cond, bar) do { unsigned _sp = 0; while (cond) { __builtin_amdgcn_s_sleep(1); \
    if ((++_sp & 255u) == 0u) { if (xb_ld(&(bar)[XB_TMO])) break; if (_sp > XB_SPIN_CAP) { atomicAdd(&(bar)[XB_TMO], 1u); break; } } } } while (0)
struct XcdBarrier { unsigned* bar; unsigned x; volatile LAS unsigned* st; };
DI XcdBarrier xcd_barrier_post(unsigned* bar, volatile LAS unsigned* st, bool leader) {
    XcdBarrier b; b.bar = bar; b.x = xb_xcc_id(); b.st = st;
    if (leader) (void)xb_add(&bar[XB_XCNT(b.x)], 1u);
    return b;
}
DI void xcd_barrier_complete(unsigned* bar, unsigned x, unsigned& nloc, unsigned& nx) {
    const unsigned G = gridDim.x * gridDim.y * gridDim.z;
    unsigned sum, cnt, mine, sp = 0u;
    for (;;) {
        sum = 0u; cnt = 0u; mine = 0u;
#pragma unroll
        for (unsigned j = 0; j < 16; ++j) { const unsigned c = xb_ld(&bar[XB_XCNT(j)]); sum += c; cnt += (c > 0u) ? 1u : 0u; mine = (j == x) ? c : mine; }
        if (sum == G) break;
        __builtin_amdgcn_s_sleep(1);
        if ((++sp & 255u) == 0u) { if (xb_ld(&bar[XB_TMO])) break; if (sp > XB_SPIN_CAP) { atomicAdd(&bar[XB_TMO], 1u); break; } }
    }
    nloc = mine > 0u ? mine : 1u; nx = cnt > 0u ? cnt : 1u;
}
DI void xcd_barrier(const XcdBarrier& b, bool leader) {
    asm volatile("s_waitcnt vmcnt(0)" ::: "memory");
    __syncthreads();
    if (leader) {
        unsigned* bar = b.bar;
        __builtin_amdgcn_s_waitcnt(0);
        unsigned nloc = b.st[0], nx = b.st[1];
        if (nloc == 0u) { xcd_barrier_complete(bar, b.x, nloc, nx); b.st[0] = nloc; b.st[1] = nx; }
        const unsigned old = xb_add(&bar[XB_XSUB(b.x)], 1u);
        const unsigned gen = old / nloc;
        if (old + 1u == (gen + 1u) * nloc) {
            __builtin_amdgcn_fence(__ATOMIC_RELEASE, "agent");
            asm volatile("s_waitcnt vmcnt(0)" ::: "memory");
            const unsigned og = xb_add(&bar[XB_TOP], 1u);
            const unsigned tg = og / nx;
            if (og + 1u == (tg + 1u) * nx) xb_add(&bar[XB_TOPGEN], 1u);
            else XB_SPIN(xb_ld(&bar[XB_TOPGEN]) == tg, bar);
            __builtin_amdgcn_fence(__ATOMIC_ACQUIRE, "agent");
            xb_add(&bar[XB_XGEN(b.x)], 1u);
            asm volatile("s_waitcnt vmcnt(0)" ::: "memory");
        } else {
            XB_SPIN(xb_ld(&bar[XB_XGEN(b.x)]) == gen, bar);
            __builtin_amdgcn_fence(__ATOMIC_ACQUIRE, "agent");
            asm volatile("s_waitcnt vmcnt(0)" ::: "memory");
        }
    }
    __syncthreads();
}

#ifndef REPEAT_MASK
#define REPEAT_MASK 0
#endif
#define PH_REP(n) ((((REPEAT_MASK) >> (n)) & 1) ? 2 : 1)
#define PHASE_BEGIN(n) if (PH_ON((n) == 15 ? 1 : (n) == 16 ? 2 : (n)) && p.ph_lo <= (n) && (n) < p.ph_hi) { for (int rep_ = 0; rep_ < PH_REP(n); ++rep_) { unsigned long long wsi_ = (unsigned long long)p.ws, hi_ = (unsigned long long)p.out; asm volatile("" : "+s"(wsi_), "+s"(hi_)); unsigned char* ws = (unsigned char*)(GAS unsigned char*)wsi_; float* H = (float*)(GAS float*)hi_;
#define PHASE_END(n) } } if (p.ph_lo <= (n) && (n) + 1 < p.ph_hi) { xcd_barrier(xbar, xlead); }
__global__ void __launch_bounds__(512, 2) fwd_kernel(Params p) {
    extern __shared__ __attribute__((aligned(16))) unsigned char shm[];
    LAS unsigned char* lds = (LAS unsigned char*)shm;
    float* smf = (float*)shm;
    const int wv = __builtin_amdgcn_readfirstlane((int)(threadIdx.x >> 6));
    const bool xlead = (wv == 0) && (lane_id() == 0);
    volatile LAS unsigned* xst = (volatile LAS unsigned*)(lds + pg8::STAGE_BYTES);
    XcdBarrier xbar; xbar.bar = nullptr; xbar.x = 0; xbar.st = xst;
    if (p.ph_hi - p.ph_lo > 1) {
        if (xlead) { xst[0] = 0u; xst[1] = 0u; }
        __syncthreads();
        xbar = xcd_barrier_post((unsigned*)(p.ws + WS_BAR), xst, xlead);
    }
    if (p.ph_lo > p.ph_hi) cg::this_grid().sync();
    using namespace pg8;
    PHASE_BEGIN(0) {
            convert_ffn_weights(p, ws, 0, smf, blockIdx.x, gridDim.x, wv, 1);
            rmsnorm_rows_bf16(p.in[0], p.in[1], p.in[5], (bf16_t*)(ws + OFF_XN), nullptr, nullptr, wv);
    } PHASE_END(0)
#define FFN_UP_BODY(spl) {     \
            Gemm g{}; g.A = (const char*)(ws + OFF_XN); g.B = (const char*)(ws + OFF_WGU); g.lda = 2048; g.ldb = 2048; g.K = 2048; g.nM = 36; g.nN = 44; g.nB = 1; g.split = spl; \
            g.a_ts = 256ll * 2048 * 2; g.b_ts = 256ll * 2048 * 2; \
            EpiSwiglu E{(bf16_t*)(ws + OFF_G), (float*)(ws + OFF_SLABG)}; \
            gemm_phase(lds, g, E, wv); }
    PHASE_BEGIN(1) FFN_UP_BODY(0)
        { const int extra = (36 * 44) % (int)gridDim.x, nconv = (int)gridDim.x - extra;
          if (extra == 0) { convert_ffn_weights(p, ws, 0, smf, blockIdx.x, gridDim.x, wv, 2); convert_other_weights(p, ws, smf, blockIdx.x, gridDim.x, wv); }
          else if ((int)blockIdx.x >= extra) { convert_ffn_weights(p, ws, 0, smf, blockIdx.x - extra, nconv, wv, 2); convert_other_weights(p, ws, smf, blockIdx.x - extra, nconv, wv); } }
    PHASE_END(1)
#define FFN_DOWN_BODY(ph) {     \
            Gemm g{}; g.A = (const char*)(ws + OFF_G); g.B = (const char*)(ws + OFF_WD); g.lda = DFF; g.ldb = DFF; g.K = DFF; g.nM = 36; g.nN = 8; g.nB = 1; g.split = 1; \
            g.a_ts = 256ll * DFF * 2; g.b_ts = 256ll * DFF * 2; \
            EpiResid E{H, ph == 2 ? p.in[0] : H, ph == 2 ? p.in[1] : H + (size_t)NPT * DM, 0.5f, (float*)(ws + OFF_SLAB), nullptr, ph == 2 ? (bf16_t*)(ws + OFF_HB) : nullptr}; \
            gemm_phase(lds, g, E, wv); }
    PHASE_BEGIN(2) FFN_DOWN_BODY(2) PHASE_END(2)
    PHASE_BEGIN(3) rmsnorm_rows_bf16(H, p.in[1], p.in[9], (bf16_t*)(ws + OFF_XN), (const float*)(ws + OFF_SLAB), H + (size_t)NPT * DM, wv, (const bf16_t*)(ws + OFF_HB)); PHASE_END(3)
    PHASE_BEGIN(4) {
            Gemm g{}; g.A = (const char*)(ws + OFF_XN); g.B = (const char*)(ws + OFF_WIN); g.lda = 2048; g.ldb = 2048; g.K = 2048; g.nM = 36; g.nN = 25; g.nB = 1;
            g.a_ts = 256ll * 2048 * 2; g.b_ts = 256ll * 2048 * 2;
            EpiWin E{(float*)(ws + OFF_Z), (float*)(ws + OFF_QLR), (float*)(ws + OFF_CKR), (bf16_t*)(ws + OFF_GATES), (bf16_t*)(ws + OFF_KRB), p.out + OUT_KR_P, p.out + OUT_KR_S, p.out + OUT_POOL_P, p.out + OUT_POOL_S};
            gemm_phase(lds, g, E, wv);
            { const int extra = (36 * 25) % (int)gridDim.x, nconv = (int)gridDim.x - extra;
              if (extra == 0) convert_cache(p, ws, smf, blockIdx.x, gridDim.x, wv); else if ((int)blockIdx.x >= extra) convert_cache(p, ws, smf, blockIdx.x - extra, nconv, wv); }
    } PHASE_END(4)
    PHASE_BEGIN(5) phase_token_local(p, ws, smf, wv);
        {
            const float* s = p.in[14]; bf16_t* d = (bf16_t*)(ws + OFF_WUKP);
            for (int i = blockIdx.x * 512 + TIDX; i < 512 * 2048 / 8; i += gridDim.x * 512) { const f32x4 a = *(const f32x4*)(s + (size_t)i * 8), c = *(const f32x4*)(s + (size_t)i * 8 + 4);
                u32x4 w; w.x = cvt_pk_bf16(a[0], a[1]); w.y = cvt_pk_bf16(a[2], a[3]); w.z = cvt_pk_bf16(c[0], c[1]); w.w = cvt_pk_bf16(c[2], c[3]); *(u32x4*)(d + (size_t)i * 8) = w; }
        }
    PHASE_END(5)
    PHASE_BEGIN(6) {
            {
                Gemm g{}; g.A = (const char*)(ws + OFF_QLAT); g.B = (const char*)(ws + OFF_WUQ); g.lda = 512; g.ldb = 512; g.K = 512; g.nM = 36; g.nN = 12; g.nB = 1;
                g.a_ts = 256ll * 512 * 2; g.b_ts = 256ll * 512 * 2;
                EpiQ E{(bf16_t*)(ws + OFF_QN), (bf16_t*)(ws + OFF_QR), (bf16_t*)(ws + OFF_QABS)};
                gemm_phase(lds, g, E, wv);
            }
            {
                Gemm g{}; g.A = (const char*)(ws + OFF_CKVP); g.B = (const char*)(ws + OFF_WUKT); g.lda = 512; g.ldb = 512; g.K = 512; g.nM = 32; g.nN = 8; g.nB = 1;
                g.a_ts = 256ll * 512 * 2; g.b_ts = 256ll * 512 * 2; g.rot = 176;
                EpiBf16 E{(bf16_t*)(ws + OFF_KN), 2048, 0, 1.0f, 0};
                gemm_phase(lds, g, E, wv);
            }
            {
                Gemm g{}; g.A = (const char*)(ws + OFF_WUVT); g.B = (const char*)(ws + OFF_CKVP); g.lda = 512; g.ldb = 512; g.K = 512; g.nM = 8; g.nN = 32; g.nB = 1;
                g.a_ts = 256ll * 512 * 2; g.b_ts = 256ll * 512 * 2; g.rot = 176;
                EpiBf16 E{(bf16_t*)(ws + OFF_VT), 8192, 0, 1.0f, 0};
                gemm_phase(lds, g, E, wv);
            }
            {
                Gemm g{}; g.A = (const char*)(ws + OFF_POOLED); g.B = (const char*)(ws + OFF_WPOOL); g.lda = 1024; g.ldb = 256; g.K = 256; g.nM = 36; g.nN = 1; g.nB = 4;
                g.a_ts = 256ll * 1024 * 2; g.b_ts = 0; g.a_bs = 512; g.b_bs = 65536ll * 2; g.rot = 176;
                EpiPoolMix E{(bf16_t*)(ws + OFF_MIXED), p.in[18]};
                gemm_phase(lds, g, E, wv);
            }
    } PHASE_END(6)
    PHASE_BEGIN(7) {
            {
                Gemm g{}; g.A = (const char*)(ws + OFF_QN) + (size_t)NPT * 2048 * 2; g.B = (const char*)(ws + OFF_WUKP); g.lda = 2048; g.ldb = 2048; g.K = 128; g.nM = 4; g.nN = 2; g.nB = 16;
                g.a_ts = 256ll * 2048 * 2; g.b_ts = 256ll * 2048 * 2; g.a_bs = 256; g.b_bs = 256; g.rot = 32;
                EpiBf16 E{(bf16_t*)(ws + OFF_QABS), 16 * 640, 640, 1.0f, 0};
                gemm_phase(lds, g, E, wv);
            }
            {
                const int c = blockIdx.x;
                for (int pr = c; pr < 256; pr += gridDim.x) {
                    const int bh = (pr & 7) * 8 + ((pr >> 3) >> 2), i = (pr >> 3) & 3;
                    attn_item(ws, lds, bh >> 4, bh & 15, 7 - i, wv);
                    attn_item(ws, lds, bh >> 4, bh & 15, i, wv);
                }
            }
    } PHASE_END(7)
    PHASE_BEGIN(8) {
            Gemm g{}; g.A = (const char*)(ws + OFF_QABS); g.B = (const char*)(ws + OFF_KALL); g.lda = 640; g.ldb = 640; g.K = 640; g.nM = 2; g.nN = 5; g.nB = 32;
            g.a_ts = 256ll * 640 * 2; g.b_ts = 256ll * 640 * 2; g.a_bs = 512ll * 640 * 2; g.b_bs = 1056ll * 640 * 2;
            EpiScore E{(_Float16*)(ws + OFF_S)};
            gemm_phase(lds, g, E, wv);
    } PHASE_END(8)
    PHASE_BEGIN(9) phase_softmax(ws, wv); PHASE_END(9)
    PHASE_BEGIN(10) {
            Gemm g{}; g.A = (const char*)(ws + OFF_P); g.B = (const char*)(ws + OFF_CKVT); g.lda = 1152; g.ldb = 1152; g.K = 1152; g.nM = 2; g.nN = 2; g.nB = 32;
            g.a_ts = 256ll * 1152 * 2; g.b_ts = 256ll * 1152 * 2; g.a_bs = 512ll * 1152 * 2; g.b_bs = 512ll * 1152 * 2;
            EpiBf16 E{(bf16_t*)(ws + OFF_OLAT), 512, 512ll * 512, 1.0f, 0};
            gemm_phase(lds, g, E, wv);
            {
                Gemm g2{}; g2.A = (const char*)(ws + OFF_MIXED); g2.B = (const char*)(ws + OFF_WPO); g2.lda = 1024; g2.ldb = 1024; g2.K = 1024; g2.nM = 36; g2.nN = 8; g2.nB = 1;
                g2.a_ts = 256ll * 1024 * 2; g2.b_ts = 256ll * 1024 * 2; g2.u0 = 0; g2.u1 = 128; g2.boff = 128; g2.nblk = (int)gridDim.x - 128;
                EpiGate E2{(bf16_t*)(ws + OFF_GA), (const bf16_t*)(ws + OFF_GATES), nullptr, 0, 0};
                gemm_phase(lds, g2, E2, wv);
            }
    } PHASE_END(10)
    PHASE_BEGIN(11) {
            {
            Gemm g{}; g.A = (const char*)(ws + OFF_OLAT); g.B = (const char*)(ws + OFF_WUVT); g.lda = 8192; g.ldb = 512; g.K = 512; g.nM = 4; g.nN = 1; g.nB = 16;
            g.a_ts = 256ll * 8192 * 2; g.b_ts = 0; g.a_bs = 512 * 2; g.b_bs = 128ll * 512 * 2;
            EpiBf16 E{(bf16_t*)(ws + OFF_O) + (size_t)NPT * 2048, 2048, 128, 1.0f, 1};
            gemm_phase(lds, g, E, wv);
            }
            {
                Gemm g{}; g.A = (const char*)(ws + OFF_MIXED); g.B = (const char*)(ws + OFF_WPO); g.lda = 1024; g.ldb = 1024; g.K = 1024; g.nM = 36; g.nN = 8; g.nB = 1;
                g.a_ts = 256ll * 1024 * 2; g.b_ts = 256ll * 1024 * 2; g.u0 = 128; g.u1 = 288; g.boff = 64; g.nblk = (int)gridDim.x - 64;
                EpiGate E{(bf16_t*)(ws + OFF_GA), (const bf16_t*)(ws + OFF_GATES), nullptr, 0, 0};
                gemm_phase(lds, g, E, wv);
            }
    } PHASE_END(11)
    PHASE_BEGIN(12) {
            Gemm g{}; g.A = (const char*)(ws + OFF_O); g.B = (const char*)(ws + OFF_WOA); g.lda = 2048; g.ldb = 2048; g.K = 2048; g.nM = 36; g.nN = 8; g.nB = 1;
            g.a_ts = 256ll * 2048 * 2; g.b_ts = 256ll * 2048 * 2;
            EpiGate E{(bf16_t*)(ws + OFF_MERGED), (const bf16_t*)(ws + OFF_GATES), (const bf16_t*)(ws + OFF_GA), 2048, 1};
            gemm_phase(lds, g, E, wv);
            { const int extra = (36 * 8) % (int)gridDim.x, nconv = (int)gridDim.x - extra;
              if (extra == 0) convert_ffn_weights(p, ws, 1, smf, blockIdx.x, gridDim.x, wv); else if ((int)blockIdx.x >= extra) convert_ffn_weights(p, ws, 1, smf, blockIdx.x - extra, nconv, wv); }
    } PHASE_END(12)
    PHASE_BEGIN(13) {
            Gemm g{}; g.A = (const char*)(ws + OFF_MERGED); g.B = (const char*)(ws + OFF_WOUT); g.lda = 2048; g.ldb = 2048; g.K = 2048; g.nM = 36; g.nN = 8; g.nB = 1; g.split = 1;
            g.a_ts = 256ll * 2048 * 2; g.b_ts = 256ll * 2048 * 2;
            EpiResid E{H, H, H + (size_t)NPT * DM, 1.0f, (float*)(ws + OFF_SLAB), (const bf16_t*)(ws + OFF_HB), nullptr};
            gemm_phase(lds, g, E, wv);
    } PHASE_END(13)
    PHASE_BEGIN(14) {
            rmsnorm_rows_bf16(H, H + (size_t)NPT * DM, p.in[21], (bf16_t*)(ws + OFF_XN), (const float*)(ws + OFF_SLAB), H + (size_t)NPT * DM, wv);
    } PHASE_END(14)
    PHASE_BEGIN(15) FFN_UP_BODY((p.ph_hi - p.ph_lo > 1) ? 2 : 0) PHASE_END(15)
    if (PH_ON(1) && p.ph_lo <= 15 && 16 < p.ph_hi) {
        unsigned long long wsi_ = (unsigned long long)p.ws; asm volatile("" : "+s"(wsi_)); unsigned char* ws = (unsigned char*)(GAS unsigned char*)wsi_;
        const int G_ = gridDim.x, nwg = 36 * 44, full = (nwg / G_) * G_, left = nwg - full, tid = TIDX;
        const int lane = tid & 63, wid = tid >> 6, wr = wid >> 2, wc = wid & 3, fr = lane & 15, fq = lane >> 4;
        const float* slab = (const float*)(ws + OFF_SLABG); bf16_t* Gout = (bf16_t*)(ws + OFF_G);
        for (int it = blockIdx.x; it < left * 16; it += G_) {
            const int lu = it >> 4, ai = (it >> 3) & 1, m = (it >> 1) & 3, n = it & 1; int pm, pn; pg8::map_unit(full + lu, 36, 44, nwg, pm, pn);
            f32x4 gs = (f32x4){0.f, 0.f, 0.f, 0.f}, us = gs;
#pragma unroll
            for (int kp = 0; kp < 4; ++kp) { const bf16_t* sp = (const bf16_t*)slab + ((size_t)(lu * 4 + kp) * 32 * 512 + tid) * 4;
                const u32x2 wg = *(const u32x2*)(sp + (size_t)(((ai * 2 + 0) * 4 + m) * 2 + n) * 2048), wu = *(const u32x2*)(sp + (size_t)(((ai * 2 + 1) * 4 + m) * 2 + n) * 2048);
                gs += (f32x4){bflo(wg.x), bfhi(wg.x), bflo(wg.y), bfhi(wg.y)}; us += (f32x4){bflo(wu.x), bfhi(wu.x), bflo(wu.y), bfhi(wu.y)}; }
            u32x2 w; w.x = cvt_pk_bf16(silu_f(gs[0]) * us[0], silu_f(gs[1]) * us[1]); w.y = cvt_pk_bf16(silu_f(gs[2]) * us[2], silu_f(gs[3]) * us[3]);
            *(u32x2*)(Gout + (size_t)(pm * 256 + ai * 128 + wr * 64 + m * 16 + fr) * DFF + pn * 128 + wc * 32 + 8 * fq + 4 * n) = w;
        }
        xcd_barrier(xbar, xlead);
    }
    PHASE_BEGIN(16) FFN_DOWN_BODY(16) PHASE_END(16)
    PHASE_BEGIN(17) {
            const int lane = lane_id(), gw = blockIdx.x * 8 + wv, nw = gridDim.x * 8; const float* gain = p.in[25];
            for (int r = gw; r < NTOK; r += nw) {
                float* sp = H + (size_t)r * DM; f32x4 v[8]; float ss = 0.f;
#pragma unroll
                for (int i = 0; i < 8; ++i) v[i] = *(const f32x4*)(sp + i * 256 + lane * 4);
                if (r >= NPT) {
#pragma unroll
                    for (int sidx = 0; sidx < 8; ++sidx) { const bf16_t* sl = (const bf16_t*)(ws + OFF_SLAB) + ((size_t)sidx * NST + (r - NPT)) * DM;
#pragma unroll
                        for (int i = 0; i < 8; ++i) { const u32x2 w = *(const u32x2*)(sl + i * 256 + lane * 4); v[i] += (f32x4){bflo(w.x), bfhi(w.x), bflo(w.y), bfhi(w.y)}; } }
                }
#pragma unroll
                for (int i = 0; i < 8; ++i) ss += v[i][0] * v[i][0] + v[i][1] * v[i][1] + v[i][2] * v[i][2] + v[i][3] * v[i][3];
                ss = wave_sum(ss); const float rstd = rsqrtf(ss * (1.0f / 2048.0f) + 1e-6f);
#pragma unroll
                for (int i = 0; i < 8; ++i) { const f32x4 g = *(const f32x4*)(gain + i * 256 + lane * 4); *(f32x4*)(sp + i * 256 + lane * 4) = v[i] * rstd * g; }
            }
    } PHASE_END(17)
}


extern "C" void kernel_launch(void* const* d_in, const int* in_sizes, int n_in, void* d_out, int out_size, void* d_ws, size_t ws_size, hipStream_t stream) {
    constexpr int LDS_BYTES = pg8::STAGE_BYTES + 16;
    static int grid = 0;
    if (grid == 0) {
        if (n_in != 26 || ws_size < WS_END || out_size != 24735744) { fprintf(stderr, "kernel_launch: unexpected problem (n_in %d, ws %zu need %zu, out %d)\n", n_in, ws_size, (size_t)WS_END, out_size); grid = -1; return; }
        int dev = 0, cus = 0, per_cu = 0;
        hipGetDevice(&dev); hipDeviceGetAttribute(&cus, hipDeviceAttributeMultiprocessorCount, dev);
        if (hipFuncSetAttribute((const void*)fwd_kernel, hipFuncAttributeMaxDynamicSharedMemorySize, LDS_BYTES) != hipSuccess) { fprintf(stderr, "kernel_launch: hipFuncSetAttribute failed\n"); grid = -1; return; }
        if (hipOccupancyMaxActiveBlocksPerMultiprocessor(&per_cu, (const void*)fwd_kernel, 512, LDS_BYTES) != hipSuccess || per_cu < 1) { fprintf(stderr, "kernel_launch: occupancy query failed (%d)\n", per_cu); (void)hipGetLastError(); per_cu = 1; }
        grid = cus * 1;
        (void)per_cu;
    }
    if (grid < 0) return;
    Params p{};
    for (int i = 0; i < 26; ++i) p.in[i] = (const float*)d_in[i];
    p.out = (float*)d_out; p.ws = (unsigned char*)d_ws;
#if SINGLE_LAUNCH
    p.ph_lo = 0; p.ph_hi = NPHASE;
    if (hipMemsetAsync((unsigned char*)d_ws + WS_BAR, 0, 16384, stream) != hipSuccess) { fprintf(stderr, "kernel_launch: memset of the barrier words failed\n"); return; }
    void* args[] = {&p};
    hipError_t e = hipLaunchCooperativeKernel((const void*)fwd_kernel, dim3(grid), dim3(512), args, LDS_BYTES, stream);
    if (e != hipSuccess) fprintf(stderr, "cooperative launch failed: %s (grid %d)\n", hipGetErrorString(e), grid);
#else
    for (int ph = 0; ph < NPHASE; ++ph) {
        p.ph_lo = ph; p.ph_hi = ph + 1;
        hipLaunchKernelGGL(fwd_kernel, dim3(grid), dim3(512), LDS_BYTES, stream, p);
    }
#endif
}
```
